# Optimizing an MI355X kernel written in HIP

```python
import math
import numpy as np
import jax
import jax.numpy as jnp
from jax import lax

D_MODEL = 1024
BATCH = 32
SEQ = 2048
DEPTH = 2

MIX_W = D_MODEL // 4
N_BRANCH = 4
POOL_GROUPS = 4
POOL_WINDOWS = (2, 4, 8, 16)
POOL_GW = MIX_W // POOL_GROUPS
GLA_HEADS = 4
GLA_DK = MIX_W // (2 * GLA_HEADS)
GLA_DV = MIX_W // GLA_HEADS
GLA_LOWRANK = 16
GLA_GATE_NORM = 16.0
GLA_CHUNK = 64
GDN_HEADS = 4
GDN_DH = MIX_W // GDN_HEADS
GDN_CONV = 4
GDN_CHUNK = 64
NSA_HEADS = 4
NSA_GROUPS = 2
NSA_HPG = NSA_HEADS // NSA_GROUPS
NSA_DH = MIX_W // NSA_HEADS
NSA_KV = NSA_GROUPS * NSA_DH
NSA_CMP_LEN = 32
NSA_CMP_STRIDE = 16
NSA_SEL_LEN = 64
NSA_N_SEL = 16
NSA_WINDOW = 512
NSA_SEL_QBLOCK = 16
NSA_WIN_QBLOCK = 128
MEM_LEN = 256
X_HEADS = 4
X_DH = 128
D_FF = 2816
FFN_CONV = 3
EPS = 1e-6
IN_SPLITS = (MIX_W,
             GLA_HEADS * GLA_DK, GLA_HEADS * GLA_DK, GLA_HEADS * GLA_DV, GLA_HEADS * GLA_DV, GLA_LOWRANK,
             MIX_W, MIX_W, MIX_W, GDN_HEADS, GDN_HEADS, MIX_W,
             NSA_HEADS * NSA_DH, NSA_KV, NSA_KV, NSA_KV, NSA_KV, NSA_KV, NSA_KV, 3 * NSA_HEADS)
N_IN = sum(IN_SPLITS)

kernel_name = 'hybrid_pool_gla_gdn_nsa_block'


def rmsnorm(x, g):
    xf = x.astype(jnp.float32)
    y = xf * lax.rsqrt(jnp.mean(xf * xf, axis=-1, keepdims=True) + EPS)
    return (y * g.astype(jnp.float32)).astype(x.dtype)


def causal_dwconv(x, w):
    width = w.shape[0]
    s = x.shape[1]
    xp = jnp.pad(x, ((0, 0), (width - 1, 0), (0, 0)))
    return sum(xp[:, i:i + s] * w[i] for i in range(width))


def masked_softmax(s, mask):
    s = jnp.where(mask, s.astype(jnp.float32), -jnp.inf)
    m = jnp.max(s, axis=-1, keepdims=True)
    m = jnp.where(jnp.isfinite(m), m, 0.0)
    e = jnp.exp(s - m)
    den = jnp.sum(e, axis=-1, keepdims=True)
    return e / jnp.where(den > 0, den, 1.0)


def _chunk(t, c):
    b, s, h = t.shape[:3]
    t = t.reshape((b, s // c, c, h) + t.shape[3:])
    return jnp.moveaxis(t, 3, 1)


def _unchunk(t):
    b, h, n, c, d = t.shape
    return jnp.moveaxis(t, 1, 3).reshape(b, n * c, h, d)


def pool_mixer(u, w_grp, scale):
    b, s, _ = u.shape
    uf = u.astype(jnp.float32).reshape(b, s, POOL_GROUPS, POOL_GW)
    cs = jnp.pad(jnp.cumsum(uf, axis=1), ((0, 0), (1, 0), (0, 0), (0, 0)))
    t = jnp.arange(s)
    pooled = []
    for gi, w in enumerate(POOL_WINDOWS):
        lo = jnp.maximum(t + 1 - w, 0)
        cnt = (t + 1 - lo).astype(jnp.float32)
        csg = cs[:, :, gi]
        pooled.append((csg[:, t + 1] - csg[:, lo]) / cnt[None, :, None])
    pooled = jnp.stack(pooled, axis=2)
    mixed = jnp.einsum('bsgc,gcd->bsgd', pooled - uf, w_grp.astype(jnp.float32))
    return (mixed.reshape(b, s, MIX_W) * scale.astype(jnp.float32)).astype(u.dtype)


def gla_mixer(q, k, v, r, lr, w_lr, b_lr, g_norm):
    b, s, _ = q.shape
    h, dk, dv, c = GLA_HEADS, GLA_DK, GLA_DV, GLA_CHUNK
    f32 = jnp.float32
    q = q.astype(f32).reshape(b, s, h, dk) * dk ** -0.5
    k = k.astype(f32).reshape(b, s, h, dk)
    v = v.astype(f32).reshape(b, s, h, dv)
    gk = jax.nn.log_sigmoid(lr.astype(f32) @ w_lr.astype(f32) + b_lr.astype(f32)) / GLA_GATE_NORM
    gk = gk.reshape(b, s, h, dk)
    qc, kc, vc, gc = (_chunk(t, c) for t in (q, k, v, gk))
    bcum = jnp.cumsum(gc, axis=3)
    blast = bcum[:, :, :, -1:, :]
    q_e = qc * jnp.exp(bcum)
    k_e = kc * jnp.exp(-bcum)
    causal = jnp.tril(jnp.ones((c, c), bool))
    att = jnp.where(causal, jnp.einsum('bhnid,bhnjd->bhnij', q_e, k_e), 0.0)
    o_intra = jnp.einsum('bhnij,bhnjv->bhniv', att, vc)
    k_upd = kc * jnp.exp(blast - bcum)
    dec = jnp.exp(blast[:, :, :, 0, :])

    def step(st, inp):
        q_n, k_n, v_n, d_n = inp
        o_n = jnp.einsum('bhcd,bhdv->bhcv', q_n, st)
        st = st * d_n[..., None] + jnp.einsum('bhcd,bhcv->bhdv', k_n, v_n)
        return st, o_n

    st0 = jnp.zeros((b, h, dk, dv), f32)
    _, o_inter = lax.scan(step, st0, tuple(jnp.moveaxis(t, 2, 0) for t in (q_e, k_upd, vc, dec)))
    o = _unchunk(o_intra + jnp.moveaxis(o_inter, 0, 2))
    o = rmsnorm(o, g_norm) * jax.nn.silu(r.astype(f32).reshape(b, s, h, dv))
    return o.reshape(b, s, MIX_W).astype(r.dtype)


def gdn_mixer(q, k, v, beta_raw, a_raw, gate, conv_w, a_log, dt_bias, g_norm):
    b, s, _ = q.shape
    h, dh, c = GDN_HEADS, GDN_DH, GDN_CHUNK
    f32 = jnp.float32
    qkv = jnp.concatenate([q, k, v], axis=-1).astype(f32)
    qkv = jax.nn.silu(causal_dwconv(qkv, conv_w.astype(f32)))
    q, k, v = (t.reshape(b, s, h, dh) for t in jnp.split(qkv, 3, axis=-1))
    q = q * lax.rsqrt(jnp.sum(q * q, axis=-1, keepdims=True) + EPS) * dh ** -0.5
    k = k * lax.rsqrt(jnp.sum(k * k, axis=-1, keepdims=True) + EPS)
    beta = jax.nn.sigmoid(beta_raw.astype(f32))
    g = -jnp.exp(a_log.astype(f32)) * jax.nn.softplus(a_raw.astype(f32) + dt_bias.astype(f32))
    qc, kc, vc, bc, gc = (_chunk(t, c) for t in (q, k, v, beta, g))
    gcum = jnp.cumsum(gc, axis=-1)
    incl = jnp.tril(jnp.ones((c, c), bool))
    strict = jnp.tril(jnp.ones((c, c), bool), -1)
    decay = jnp.exp(jnp.where(incl, gcum[..., :, None] - gcum[..., None, :], -jnp.inf))
    kb = kc * bc[..., None]
    vb = vc * bc[..., None]
    a_mat = jnp.where(strict, jnp.einsum('bhnid,bhnjd->bhnij', kb, kc) * decay, 0.0) + jnp.eye(c, dtype=f32)
    u = lax.linalg.triangular_solve(a_mat, vb, left_side=True, lower=True, unit_diagonal=True)
    w = lax.linalg.triangular_solve(a_mat, kb * jnp.exp(gcum)[..., None], left_side=True, lower=True,
                                    unit_diagonal=True)
    a_qk = jnp.einsum('bhnid,bhnjd->bhnij', qc, kc) * decay
    q_dec = qc * jnp.exp(gcum)[..., None]
    k_dec = kc * jnp.exp(gcum[..., -1:] - gcum)[..., None]
    dec = jnp.exp(gcum[..., -1])

    def step(st, inp):
        u_n, w_n, qd_n, aqk_n, kd_n, d_n = inp
        v_new = u_n - jnp.einsum('bhcd,bhdv->bhcv', w_n, st)
        o_n = jnp.einsum('bhcd,bhdv->bhcv', qd_n, st) + jnp.einsum('bhij,bhjv->bhiv', aqk_n, v_new)
        st = st * d_n[..., None, None] + jnp.einsum('bhcd,bhcv->bhdv', kd_n, v_new)
        return st, o_n

    st0 = jnp.zeros((b, h, dh, dh), f32)
    _, o = lax.scan(step, st0, tuple(jnp.moveaxis(t, 2, 0) for t in (u, w, q_dec, a_qk, k_dec, dec)))
    o = _unchunk(jnp.moveaxis(o, 0, 2))
    o = rmsnorm(o, g_norm) * jax.nn.silu(gate.astype(f32).reshape(b, s, h, dh))
    return o.reshape(b, s, MIX_W).astype(gate.dtype)


def _compress(t, pe, w1, w2):
    b, s, g, dh = t.shape
    n_sub = NSA_CMP_LEN // NSA_CMP_STRIDE
    n_chunks = s // NSA_CMP_STRIDE
    n_cmp = n_chunks - n_sub + 1
    tc = t.reshape(b, n_chunks, NSA_CMP_STRIDE, g, dh)
    blk = jnp.concatenate([tc[:, i:i + n_cmp] for i in range(n_sub)], axis=2)
    blk = blk + pe[None, None, :, None, :]
    flat = jnp.moveaxis(blk, 3, 2).reshape(b, n_cmp, g, NSA_CMP_LEN * dh)
    return jax.nn.gelu(flat @ w1) @ w2


def nsa_mixer(q, kc, vc, ks, vs, kw, vw, gate_raw, pe, cmp_w1, cmp_w2):
    b, s, _ = q.shape
    g, j, dh = NSA_GROUPS, NSA_HPG, NSA_DH
    f32 = jnp.float32
    scale = dh ** -0.5
    q = q.astype(f32).reshape(b, s, g, j, dh)
    kc, vc, ks, vs, kw, vw = (t.astype(f32).reshape(b, s, g, dh) for t in (kc, vc, ks, vs, kw, vw))
    t_pos = jnp.arange(s)

    ck = _compress(kc, pe[0], cmp_w1[0], cmp_w2[0])
    cv = _compress(vc, pe[1], cmp_w1[1], cmp_w2[1])
    n_cmp = ck.shape[1]
    cmp_end = jnp.arange(n_cmp) * NSA_CMP_STRIDE + NSA_CMP_LEN - 1
    p_cmp = masked_softmax(jnp.einsum('bsgjd,bngd->bgjsn', q, ck) * scale,
                           cmp_end[None, :] <= t_pos[:, None])
    o_cmp = jnp.einsum('bgjsn,bngd->bsgjd', p_cmp, cv)

    n_slc = s // NSA_SEL_LEN
    c_start = np.arange(n_cmp) * NSA_CMP_STRIDE
    s_start = np.arange(n_slc) * NSA_SEL_LEN
    cover = ((c_start[:, None] <= s_start[None, :] + NSA_SEL_LEN - 1)
             & (c_start[:, None] + NSA_CMP_LEN - 1 >= s_start[None, :])).astype(np.float32)
    imp = jnp.einsum('bgjsn,nm->bgsm', p_cmp, jnp.asarray(cover))
    blk = jnp.arange(n_slc)[None, :]
    cur = (t_pos // NSA_SEL_LEN)[:, None]
    forced = (blk == 0) | (blk == cur) | (blk == cur - 1)
    imp = jnp.where(forced, jnp.inf, jnp.where(blk > cur, -jnp.inf, imp))
    n_top = min(NSA_N_SEL, n_slc)
    _, idx = lax.top_k(imp, n_top)

    qb_len = NSA_SEL_QBLOCK
    nqb = s // qb_len
    ks_b = jnp.moveaxis(ks.reshape(b, n_slc, NSA_SEL_LEN, g, dh), 3, 1)
    vs_b = jnp.moveaxis(vs.reshape(b, n_slc, NSA_SEL_LEN, g, dh), 3, 1)
    gather = jax.vmap(jax.vmap(lambda tab, ii: tab[ii]))
    q_blocks = jnp.moveaxis(q.reshape(b, nqb, qb_len, g, j, dh), 1, 0)
    idx_blocks = jnp.moveaxis(idx.reshape(b, g, nqb, qb_len, n_top), 2, 0)
    pos_blocks = t_pos.reshape(nqb, qb_len)
    within = jnp.arange(NSA_SEL_LEN)

    def sel_block(args):
        qb, ib, pb = args
        kg = gather(ks_b, ib)
        vg = gather(vs_b, ib)
        kpos = ib[..., None] * NSA_SEL_LEN + within
        valid = (kpos <= pb[None, None, :, None, None]).reshape(b, g, 1, qb_len, n_top * NSA_SEL_LEN)
        sc = jnp.einsum('bqgjd,bgqkld->bgjqkl', qb, kg) * scale
        p = masked_softmax(sc.reshape(b, g, j, qb_len, n_top * NSA_SEL_LEN), valid).reshape(sc.shape)
        return jnp.einsum('bgjqkl,bgqkld->bqgjd', p, vg)

    o_slc = lax.map(sel_block, (q_blocks, idx_blocks, pos_blocks))
    o_slc = jnp.moveaxis(o_slc, 0, 1).reshape(b, s, g, j, dh)

    qw_len = NSA_WIN_QBLOCK
    span = NSA_WINDOW + qw_len
    nqw = s // qw_len
    kw_p = jnp.pad(kw, ((0, 0), (NSA_WINDOW, 0), (0, 0), (0, 0)))
    vw_p = jnp.pad(vw, ((0, 0), (NSA_WINDOW, 0), (0, 0), (0, 0)))
    qw_blocks = jnp.moveaxis(q.reshape(b, nqw, qw_len, g, j, dh), 1, 0)
    starts = jnp.arange(nqw) * qw_len

    def win_block(args):
        qb, st = args
        kb = lax.dynamic_slice_in_dim(kw_p, st, span, axis=1)
        vb = lax.dynamic_slice_in_dim(vw_p, st, span, axis=1)
        qp = st + jnp.arange(qw_len)
        kp = st - NSA_WINDOW + jnp.arange(span)
        valid = (kp[None, :] <= qp[:, None]) & (kp[None, :] > qp[:, None] - NSA_WINDOW) & (kp[None, :] >= 0)
        p = masked_softmax(jnp.einsum('bqgjd,bkgd->bgjqk', qb, kb) * scale, valid)
        return jnp.einsum('bgjqk,bkgd->bqgjd', p, vb)

    o_win = lax.map(win_block, (qw_blocks, starts))
    o_win = jnp.moveaxis(o_win, 0, 1).reshape(b, s, g, j, dh)

    gt = jax.nn.sigmoid(gate_raw.astype(f32)).reshape(b, s, g, j, 3)
    o = gt[..., 0:1] * o_cmp + gt[..., 1:2] * o_slc + gt[..., 2:3] * o_win
    return o.reshape(b, s, MIX_W).astype(gate_raw.dtype)


def mem_cross_attn(h, mem_n, w_q, w_kv, w_o):
    b, s, _ = h.shape
    m = mem_n.shape[1]
    q = (h @ w_q).reshape(b, s, X_HEADS, X_DH)
    kv = (mem_n @ w_kv).reshape(b, m, 2, X_HEADS, X_DH)
    sc = jnp.einsum('bshd,bmhd->bhsm', q, kv[:, :, 0]).astype(jnp.float32) * X_DH ** -0.5
    p = jax.nn.softmax(sc, axis=-1).astype(kv.dtype)
    o = jnp.einsum('bhsm,bmhd->bshd', p, kv[:, :, 1]).reshape(b, s, X_HEADS * X_DH)
    return o @ w_o


def conv_ffn(h, w_up, conv_w, conv_b, w_down):
    u, v = jnp.split(h @ w_up, 2, axis=-1)
    u = causal_dwconv(u, conv_w) + conv_b
    return (jax.nn.gelu(u) * v) @ w_down


def setup_inputs(seed: int = 0) -> dict:
    key = jax.random.key(seed)
    k = jax.random.split(key, 32)
    f32 = jnp.float32
    L = DEPTH

    def nrm(i, shape, fan_in):
        return jax.random.normal(k[i], shape, f32) * fan_in ** -0.5

    def gain(i, shape):
        return 1.0 + 0.02 * jax.random.normal(k[i], shape, f32)

    def small(i, shape):
        return 0.01 * jax.random.normal(k[i], shape, f32)

    dt = jnp.exp(jax.random.uniform(k[11], (L, GDN_HEADS), f32, math.log(1e-3), math.log(1e-1)))
    return {
        'x': jax.random.normal(k[0], (BATCH, SEQ, D_MODEL), f32),
        'mem': jax.random.normal(k[1], (BATCH, MEM_LEN, D_MODEL), f32),
        'g_mix': gain(2, (L, D_MODEL)),
        'w_in': nrm(3, (L, D_MODEL, N_IN), D_MODEL),
        'pool_w': nrm(4, (L, POOL_GROUPS, POOL_GW, POOL_GW), POOL_GW),
        'pool_scale': gain(5, (L, MIX_W)),
        'gla_w_lr': nrm(6, (L, GLA_LOWRANK, GLA_HEADS * GLA_DK), GLA_LOWRANK),
        'gla_b_lr': small(7, (L, GLA_HEADS * GLA_DK)),
        'gla_g_norm': gain(8, (L, GLA_DV)),
        'gdn_conv': nrm(9, (L, GDN_CONV, 3 * MIX_W), GDN_CONV),
        'gdn_a_log': jnp.log(jax.random.uniform(k[10], (L, GDN_HEADS), f32, 1.0, 16.0)),
        'gdn_dt_bias': dt + jnp.log(-jnp.expm1(-dt)),
        'gdn_g_norm': gain(12, (L, GDN_DH)),
        'nsa_pe': 0.1 * jax.random.normal(k[13], (L, 2, NSA_CMP_LEN, NSA_DH), f32),
        'nsa_cmp_w1': nrm(14, (L, 2, NSA_CMP_LEN * NSA_DH, NSA_DH), NSA_CMP_LEN * NSA_DH),
        'nsa_cmp_w2': nrm(15, (L, 2, NSA_DH, NSA_DH), NSA_DH),
        'w_branch': nrm(16, (L, N_BRANCH, MIX_W, D_MODEL), MIX_W),
        'w_gate': nrm(17, (L, N_BRANCH, D_MODEL, D_MODEL), D_MODEL),
        'b_gate': small(18, (L, N_BRANCH, D_MODEL)),
        'w_out': nrm(19, (L, D_MODEL, D_MODEL), D_MODEL),
        'g_cross': gain(20, (L, D_MODEL)),
        'g_mem': gain(21, (L, D_MODEL)),
        'w_xq': nrm(22, (L, D_MODEL, X_HEADS * X_DH), D_MODEL),
        'w_mem_kv': nrm(23, (L, D_MODEL, 2 * X_HEADS * X_DH), D_MODEL),
        'w_xo': nrm(24, (L, X_HEADS * X_DH, D_MODEL), X_HEADS * X_DH),
        'g_ffn': gain(25, (L, D_MODEL)),
        'w_up': nrm(26, (L, D_MODEL, 2 * D_FF), D_MODEL),
        'ffn_conv': nrm(27, (L, FFN_CONV, D_FF), FFN_CONV),
        'ffn_conv_b': small(28, (L, D_FF)),
        'w_down': nrm(29, (L, D_FF, D_MODEL), D_FF),
        'g_final': gain(30, (D_MODEL,)),
    }


def reference(x, mem, g_mix, w_in, pool_w, pool_scale, gla_w_lr, gla_b_lr, gla_g_norm, gdn_conv,
              gdn_a_log, gdn_dt_bias, gdn_g_norm, nsa_pe, nsa_cmp_w1, nsa_cmp_w2, w_branch, w_gate,
              b_gate, w_out, g_cross, g_mem, w_xq, w_mem_kv, w_xo, g_ffn, w_up, ffn_conv, ffn_conv_b,
              w_down, g_final):
    bounds = [int(v) for v in np.cumsum(IN_SPLITS)[:-1]]
    for l in range(DEPTH):
        h = rmsnorm(x, g_mix[l])
        z = h @ w_in[l]
        (p_in, a_q, a_k, a_v, a_r, a_lr, d_q, d_k, d_v, d_b, d_a, d_g,
         n_q, n_kc, n_vc, n_ks, n_vs, n_kw, n_vw, n_g) = jnp.split(z, bounds, axis=-1)
        branches = [
            pool_mixer(p_in, pool_w[l], pool_scale[l]),
            gla_mixer(a_q, a_k, a_v, a_r, a_lr, gla_w_lr[l], gla_b_lr[l], gla_g_norm[l]),
            gdn_mixer(d_q, d_k, d_v, d_b, d_a, d_g, gdn_conv[l], gdn_a_log[l], gdn_dt_bias[l], gdn_g_norm[l]),
            nsa_mixer(n_q, n_kc, n_vc, n_ks, n_vs, n_kw, n_vw, n_g, nsa_pe[l], nsa_cmp_w1[l], nsa_cmp_w2[l]),
        ]
        y = 0.0
        for i in range(N_BRANCH):
            gate = jax.nn.sigmoid(h @ w_gate[l, i] + b_gate[l, i])
            y = y + gate * (branches[i] @ w_branch[l, i])
        x = x + y @ w_out[l]
        x = x + mem_cross_attn(rmsnorm(x, g_cross[l]), rmsnorm(mem, g_mem[l]), w_xq[l], w_mem_kv[l], w_xo[l])
        x = x + conv_ffn(rmsnorm(x, g_ffn[l]), w_up[l], ffn_conv[l], ffn_conv_b[l], w_down[l])
    return rmsnorm(x, g_final)
```

```cpp
#include <hip/hip_runtime.h>
#include <cstdio>
#include <cstdint>

#ifndef PROBE_REP_GEMM
#define PROBE_REP_GEMM 0
#endif
#ifndef PROBE_REP_MIX
#define PROBE_REP_MIX 0
#endif
#ifndef PROBE_REP_MEM
#define PROBE_REP_MEM 0
#endif
#ifndef MK_N_LAUNCHES
#define MK_N_LAUNCHES 1
#endif

#define GAS __attribute__((address_space(1)))
#define LAS __attribute__((address_space(3)))
typedef unsigned short bf16_t;
typedef short bf16x8 __attribute__((ext_vector_type(8)));
typedef float f32x4 __attribute__((ext_vector_type(4)));
typedef float f32x16 __attribute__((ext_vector_type(16)));
typedef unsigned u32x4 __attribute__((ext_vector_type(4)));
typedef unsigned u32x2 __attribute__((ext_vector_type(2)));

constexpr int NB = 32, SEQ = 2048, T = NB * SEQ, DM = 1024, NLAYER = 2;
constexpr int NZ = 3072, NZS = 64, NWIN = 3328;
constexpr int DFF = 2816, NUP = 2 * DFF, MEML = 256;
constexpr int TH = T / 2;
constexpr float EPS = 1e-6f;
constexpr int ZC_POOL = 0, ZC_AQ = 256, ZC_AK = 384, ZC_AV = 512, ZC_AR = 768;
constexpr int ZC_DQ = 1024, ZC_DK = 1280, ZC_DV = 1536, ZC_DG = 1792;
constexpr int ZC_NQ = 2048, ZC_NKC = 2304, ZC_NVC = 2432, ZC_NKS = 2560, ZC_NVS = 2688, ZC_NKW = 2816, ZC_NVW = 2944;
constexpr int ZS_LR = 0, ZS_DB = 16, ZS_DA = 20, ZS_NG = 24;

constexpr size_t MiB = 1u << 20;
constexpr size_t WS_CTL = 0, CTL_ZERO_BYTES = 1 * MiB;
constexpr size_t WS_W = 2 * MiB, W_STRIDE = 40 * MiB;
constexpr size_t WO_IN = 0, WO_G = 7 * MiB, WO_B = 15 * MiB, WO_OUT = 17 * MiB, WO_XQ = 19 * MiB, WO_KV = 20 * MiB, WO_XO = 22 * MiB,
                 WO_UP = 23 * MiB, WO_DN = 34 * MiB, WO_C1 = 39 * MiB + MiB / 2;
constexpr size_t WS_MEMKV = 82 * MiB;
constexpr size_t WS_VTMEM = 114 * MiB;
constexpr size_t WS_ZS = 130 * MiB;
constexpr size_t WS_CK = 146 * MiB;
constexpr size_t WS_CVT = 147 * MiB;
constexpr size_t WS_PH = 148 * MiB;
constexpr size_t WS_VTS = 156 * MiB;
constexpr size_t WS_VTW = 172 * MiB;
constexpr size_t WS_XQ = 188 * MiB;
constexpr size_t WS_C0P = 252 * MiB;
constexpr size_t WS_SS = 253 * MiB;
constexpr size_t WS_H = 256 * MiB;
constexpr size_t WS_Z = 384 * MiB;
constexpr size_t WS_O = 768 * MiB;
constexpr size_t WS_Y = 896 * MiB;
constexpr size_t WS_END = 1024 * MiB;
constexpr size_t WS_SCR = WS_Z;
constexpr size_t WS_UV = WS_Z;
constexpr size_t WS_ACT = WS_Z;
constexpr size_t WS_STASH = WS_XQ;
constexpr size_t WS_MEMN = WS_O;
constexpr size_t WS_GDN_S = WS_Y;
constexpr size_t WS_GDN_P = WS_Y + 64 * MiB;
constexpr size_t WS_GLA_S = WS_XQ;
constexpr size_t WS_GLA_D = WS_XQ + 32 * MiB;
constexpr size_t WS_GDN_KT = WS_Y, WS_GDN_QN = WS_Y + 32 * MiB, WS_GDN_KN = WS_Y + 64 * MiB, WS_GDN_XVT = WS_Y + 96 * MiB;
constexpr size_t WS_GDN_AB = WS_XQ + 48 * MiB;
constexpr size_t WS_GLA_KUT = WS_XQ, WS_GLA_QE = WS_XQ + 16 * MiB, WS_GLA_KE = WS_XQ + 32 * MiB, WS_GLA_DEC = WS_XQ + 50 * MiB;
constexpr int CW_QUEUE = 8192;
constexpr int CW_BAR = 4096;

constexpr int RING_BYTES = 131072;
constexpr int MISC_OFF = RING_BYTES + 320;
constexpr int LDS_BYTES = 163840;
constexpr int NWAVES = 8;

__device__ __forceinline__ float bf2f(unsigned v) { return __uint_as_float(v << 16); }
__device__ __forceinline__ unsigned f2bf(float f) { unsigned u = __float_as_uint(f); return (u + 0x7fffu + ((u >> 16) & 1u)) >> 16; }
__device__ __forceinline__ unsigned pk2(float lo, float hi) { return f2bf(lo) | (f2bf(hi) << 16); }
__device__ __forceinline__ u32x4 cvt8(float a0, float a1, float a2, float a3, float a4, float a5, float a6, float a7) {
    u32x4 p;
    asm("s_nop 11\n\tv_cvt_pk_bf16_f32 %0, %4, %5\n\tv_cvt_pk_bf16_f32 %1, %6, %7\n\tv_cvt_pk_bf16_f32 %2, %8, %9\n\tv_cvt_pk_bf16_f32 %3, %10, %11\n\ts_nop 1"
        : "=&v"(p[0]), "=&v"(p[1]), "=&v"(p[2]), "=&v"(p[3]) : "v"(a0), "v"(a1), "v"(a2), "v"(a3), "v"(a4), "v"(a5), "v"(a6), "v"(a7));
    return p;
}
__device__ __forceinline__ float rdlane(float v, int l) { return __int_as_float(__builtin_amdgcn_readlane(__float_as_int(v), l)); }
#define DPP_ADD_(v, ctrl, rmask) v += __int_as_float(__builtin_amdgcn_update_dpp(0, __float_as_int(v), ctrl, rmask, 0xf, false))
__device__ __forceinline__ float wave_sum(float v) {
    DPP_ADD_(v, 0xB1, 0xf);
    DPP_ADD_(v, 0x4E, 0xf);
    DPP_ADD_(v, 0x141, 0xf);
    DPP_ADD_(v, 0x140, 0xf);
    DPP_ADD_(v, 0x142, 0xa);
    DPP_ADD_(v, 0x143, 0xc);
    return rdlane(v, 63);
}
__device__ __forceinline__ float sigmoidf_(float x) { return __builtin_amdgcn_rcpf(1.0f + __expf(-x)); }
__device__ __forceinline__ float siluf_(float x) { return x * __builtin_amdgcn_rcpf(1.0f + __expf(-x)); }
__device__ __forceinline__ float softplusf_(float x) { return x > 20.f ? x : log1pf(__expf(x)); }
__device__ __forceinline__ float gelu_tanh(float x) {
    const float y = 0.7978845608028654f * (x + 0.044715f * x * x * x);
    const float e = __expf(2.0f * y);
    const float th = 1.0f - 2.0f * __builtin_amdgcn_rcpf(e + 1.0f);
    return 0.5f * x * (1.0f + th);
}
#define LDS_FENCE() asm volatile("s_waitcnt lgkmcnt(0)" ::: "memory")
__device__ __forceinline__ void unpack8(const u32x4& a, float (&f)[8]) {
    f[0] = bf2f(a.x & 0xffff); f[1] = bf2f(a.x >> 16); f[2] = bf2f(a.y & 0xffff); f[3] = bf2f(a.y >> 16); f[4] = bf2f(a.z & 0xffff); f[5] = bf2f(a.z >> 16); f[6] = bf2f(a.w & 0xffff); f[7] = bf2f(a.w >> 16);
}

#define XB_TMO      128
#define XB_XCNT(j)  (256  + 64 * (j))
#define XB_XSUB(j)  (1280 + 64 * (j))
#define XB_XGEN(j)  (2304 + 64 * (j))
#define XB_TOP      3328
#define XB_TOPGEN   3392
#define XCD_BAR_WORDS 3456
#define XB_SPIN_CAP (1u << 18)
__device__ __forceinline__ unsigned xb_ld(unsigned* p)              { return __hip_atomic_load(p, __ATOMIC_RELAXED, __HIP_MEMORY_SCOPE_AGENT); }
__device__ __forceinline__ unsigned xb_add(unsigned* p, unsigned v) { return __hip_atomic_fetch_add(p, v, __ATOMIC_RELAXED, __HIP_MEMORY_SCOPE_AGENT); }
__device__ __forceinline__ unsigned xb_xcc_id() { return (unsigned)__builtin_amdgcn_s_getreg((3 << 11) | 20) & 0xFu; }
#define XB_SPIN(cond, bar) do { unsigned _sp = 0; while (cond) { __builtin_amdgcn_s_sleep(1); \
    if ((++_sp & 255u) == 0u) { if (xb_ld(&(bar)[XB_TMO])) break; if (_sp > XB_SPIN_CAP) { atomicAdd(&(bar)[XB_TMO], 1u); break; } } } } while (0)
struct XcdBarrier { unsigned* bar; unsigned x; volatile LAS unsigned* st; };
__device__ __forceinline__ XcdBarrier xcd_barrier_post(unsigned* bar, volatile LAS unsigned* st) {
    XcdBarrier b; b.bar = bar; b.x = xb_xcc_id(); b.st = st;
    if (threadIdx.x == 0) (void)xb_add(&bar[XB_XCNT(b.x)], 1u);
    return b;
}
__device__ __forceinline__ void xcd_barrier_complete(unsigned* bar, unsigned x, unsigned& nloc, unsigned& nx) {
    const unsigned G = gridDim.x * gridDim.y * gridDim.z;
    unsigned sum, cnt, mine, sp = 0u;
    for (;;) {
        sum = 0u; cnt = 0u; mine = 0u;
#pragma unroll
        for (unsigned j = 0; j < 16; ++j) { const unsigned c = xb_ld(&bar[XB_XCNT(j)]); sum += c; cnt += (c > 0u) ? 1u : 0u; mine = (j == x) ? c : mine; }
        if (sum == G) break;
        __builtin_amdgcn_s_sleep(1);
        if ((++sp & 255u) == 0u) { if (xb_ld(&bar[XB_TMO])) break; if (sp > XB_SPIN_CAP) { atomicAdd(&bar[XB_TMO], 1u); break; } }
    }
    nloc = mine > 0u ? mine : 1u; nx = cnt > 0u ? cnt : 1u;
}
__device__ __forceinline__ void xcd_barrier(const XcdBarrier& b) {
    asm volatile("s_waitcnt vmcnt(0)" ::: "memory");
    __syncthreads();
    if (threadIdx.x == 0) {
        unsigned* bar = b.bar;
        __builtin_amdgcn_s_waitcnt(0);
        unsigned nloc = b.st[0], nx = b.st[1];
        if (nloc == 0u) { xcd_barrier_complete(bar, b.x, nloc, nx); b.st[0] = nloc; b.st[1] = nx; }
        const unsigned old = xb_add(&bar[XB_XSUB(b.x)], 1u);
        const unsigned gen = old / nloc;
        if (old + 1u == (gen + 1u) * nloc) {
            __builtin_amdgcn_fence(__ATOMIC_RELEASE, "agent");
            asm volatile("s_waitcnt vmcnt(0)" ::: "memory");
            const unsigned og = xb_add(&bar[XB_TOP], 1u);
            const unsigned tg = og / nx;
            if (og + 1u == (tg + 1u) * nx) xb_add(&bar[XB_TOPGEN], 1u);
            else XB_SPIN(xb_ld(&bar[XB_TOPGEN]) == tg, bar);
            __builtin_amdgcn_fence(__ATOMIC_ACQUIRE, "agent");
            xb_add(&bar[XB_XGEN(b.x)], 1u);
            asm volatile("s_waitcnt vmcnt(0)" ::: "memory");
        } else {
            XB_SPIN(xb_ld(&bar[XB_XGEN(b.x)]) == gen, bar);
            __builtin_amdgcn_fence(__ATOMIC_ACQUIRE, "agent");
            asm volatile("s_waitcnt vmcnt(0)" ::: "memory");
        }
    }
    __syncthreads();
}

namespace pg8 {
constexpr int BM = 256, BK = 64, HALF = 128, HTB = HALF * BK * 2, STAGE_BYTES = 8 * HTB;
__host__ __device__ __forceinline__ int lds_byte(int r, int c) { const int st = (r >> 4) * 2 + (c >> 5), rr = r & 15, cc = c & 31, ob = rr * 64 + cc * 2; return st * 1024 + (ob ^ (((ob >> 9) & 1) << 5)); }
__host__ __device__ __forceinline__ void stage_rc(int b, int& R, int& C) { const int st = b / 1024, sb = b % 1024, swz = sb ^ (((sb >> 9) & 1) << 5); R = (st >> 1) * 16 + swz / 64; C = (st & 1) * 32 + (swz % 64) / 2; }
__host__ __device__ __forceinline__ int perm32(int rho) { const int n = rho >> 4, i = rho & 15; return 8 * (i >> 2) + 4 * n + (i & 3); }

struct GUnit { const char* A; const char* B; int nt, kind, row0, col0, aux; };

template <class Epi, class Sched>
__device__ __forceinline__ void gemm_phase(LAS unsigned char* lds, const int tid, const int ld, const Sched& S, const Epi& E) {
    const int wid = __builtin_amdgcn_readfirstlane(tid >> 6), lane = tid & 63, wr = wid >> 2, wc = wid & 3, fr = lane & 15, fq = lane >> 4;
    unsigned voffA[2], voffB[2];
#pragma unroll
    for (int i = 0; i < 2; ++i) { int R, C; stage_rc(tid * 16 + i * 8192, R, C); const int Rb = (R & ~31) + perm32(R & 31);
        voffA[i] = (unsigned)(R * ld + C) * 2u; voffB[i] = (unsigned)(Rb * ld + C) * 2u; }
    const size_t kstep = (size_t)(BK * 2);
    const size_t hstep = (size_t)HALF * ld * 2;
    const unsigned ldsw = (unsigned)wid * 1024u;
    const int aoff = lds_byte(wr * 64 + fr, fq * 8), boff = lds_byte(wc * 32 + fr, fq * 8);
#define PG8_SA(b, h) (((b) * 2 + (h)) * HTB)
#define PG8_SB(b, h) ((4 + (b) * 2 + (h)) * HTB)
#define PG8_STAGE(bufoff, gbase, voff) do { _Pragma("unroll") for (int _i = 0; _i < 2; ++_i) \
        __builtin_amdgcn_global_load_lds((const unsigned*)((const char*)(gbase) + (voff)[_i]), (LAS unsigned*)(lds + (bufoff) + ldsw + _i * 8192), 16, 0, 0); } while (0)
#define PG8_LDA(dst, b, h) do { _Pragma("unroll") for (int m = 0; m < 4; ++m) _Pragma("unroll") for (int k = 0; k < 2; ++k) dst[m][k] = *(const LAS bf16x8*)(lds + PG8_SA(b, h) + aoff + m * 2048 + k * 1024); } while (0)
#define PG8_LDB(dst, b, h) do { _Pragma("unroll") for (int n = 0; n < 2; ++n) _Pragma("unroll") for (int k = 0; k < 2; ++k) dst[n][k] = *(const LAS bf16x8*)(lds + PG8_SB(b, h) + boff + n * 2048 + k * 1024); } while (0)
#define PG8_MMA(ai, bj, At, Bt) do { __builtin_amdgcn_s_setprio(1); _Pragma("unroll") for (int m = 0; m < 4; ++m) _Pragma("unroll") for (int n = 0; n < 2; ++n) _Pragma("unroll") for (int k = 0; k < 2; ++k) \
        acc[ai][bj][m][n] = __builtin_amdgcn_mfma_f32_16x16x32_bf16(Bt[n][k], At[m][k], acc[ai][bj][m][n], 0, 0, 0); __builtin_amdgcn_s_setprio(0); } while (0)
#define PG8_WAIT_V(n) asm volatile("s_waitcnt vmcnt(" #n ")" ::: "memory")
#define PG8_WAIT_L(n) asm volatile("s_waitcnt lgkmcnt(" #n ")" ::: "memory")
#define PG8_BAR __builtin_amdgcn_s_barrier()
#define PG8_SCHED __builtin_amdgcn_sched_barrier(0)
    GUnit cur, nxt; int ui = 0;
    if (!S.next(0, cur)) return;
    f32x4 acc[2][2][4][2];
#pragma unroll
    for (int a = 0; a < 2; ++a)
#pragma unroll
        for (int b = 0; b < 2; ++b)
#pragma unroll
            for (int m = 0; m < 4; ++m)
#pragma unroll
                for (int n = 0; n < 2; ++n) acc[a][b][m][n] = (f32x4){0.f, 0.f, 0.f, 0.f};
    bf16x8 At[4][2], B0[2][2], B1[2][2];
    const char* cA = cur.A; const char* cB = cur.B;
    PG8_STAGE(PG8_SB(0, 0), cB, voffB); PG8_STAGE(PG8_SB(0, 1), cB + hstep, voffB); PG8_STAGE(PG8_SA(0, 0), cA, voffA); PG8_STAGE(PG8_SA(0, 1), cA + hstep, voffA);
    if (wr == 1) PG8_BAR;
    PG8_WAIT_V(2); PG8_BAR;
    PG8_STAGE(PG8_SB(1, 0), cB + kstep, voffB); PG8_STAGE(PG8_SA(1, 0), cA + kstep, voffA); PG8_STAGE(PG8_SB(1, 1), cB + hstep + kstep, voffB);
    PG8_WAIT_V(6); PG8_BAR;
    for (;;) {
        const bool has_next = S.next(ui + 1, nxt);
        const char* nA = has_next ? nxt.A : cA; const char* nB = has_next ? nxt.B : cB;
        const int nt = cur.nt;
        for (int t = 0; t < nt; t += 2) {
            const bool last = (t == nt - 2);
            const char* a1 = cA + (size_t)(t + 1) * kstep;
            const char* a2 = last ? nA : cA + (size_t)(t + 2) * kstep; const char* b2 = last ? nB : cB + (size_t)(t + 2) * kstep;
            const char* a3 = a2 + kstep; const char* b3 = b2 + kstep;
            PG8_LDB(B0, 0, 0); PG8_LDB(B1, 0, 1); PG8_SCHED; PG8_LDA(At, 0, 0); PG8_STAGE(PG8_SA(1, 1), a1 + hstep, voffA);
            PG8_WAIT_V(8); PG8_WAIT_L(0); PG8_BAR; PG8_MMA(0, 0, At, B0); PG8_MMA(0, 1, At, B1); PG8_BAR; PG8_SCHED;
            PG8_LDA(At, 0, 1); PG8_STAGE(PG8_SB(0, 0), b2, voffB); PG8_STAGE(PG8_SB(0, 1), b2 + hstep, voffB); PG8_STAGE(PG8_SA(0, 0), a2, voffA);
            PG8_WAIT_V(8); PG8_WAIT_L(0); PG8_BAR; PG8_MMA(1, 0, At, B0); PG8_MMA(1, 1, At, B1); PG8_BAR; PG8_SCHED;
            PG8_LDB(B0, 1, 0); PG8_LDB(B1, 1, 1); PG8_SCHED; PG8_LDA(At, 1, 0); PG8_STAGE(PG8_SA(0, 1), a2 + hstep, voffA);
            PG8_WAIT_V(8); PG8_WAIT_L(0); PG8_BAR; PG8_MMA(0, 0, At, B0); PG8_MMA(0, 1, At, B1); PG8_BAR; PG8_SCHED;
            PG8_LDA(At, 1, 1); PG8_STAGE(PG8_SB(1, 0), b3, voffB); PG8_STAGE(PG8_SB(1, 1), b3 + hstep, voffB); PG8_STAGE(PG8_SA(1, 0), a3, voffA);
            PG8_WAIT_V(8); PG8_WAIT_L(0); PG8_BAR; PG8_MMA(1, 0, At, B0); PG8_MMA(1, 1, At, B1); PG8_BAR; PG8_SCHED;
        }
        if (wr == 0) PG8_BAR;
        asm volatile("s_nop 15" ::: "memory");
        E(acc, cur, wr, wc, fr, fq, tid);
        if (!has_next) break;
#pragma unroll
        for (int a = 0; a < 2; ++a)
#pragma unroll
            for (int b = 0; b < 2; ++b)
#pragma unroll
                for (int m = 0; m < 4; ++m)
#pragma unroll
                    for (int n = 0; n < 2; ++n) acc[a][b][m][n] = (f32x4){0.f, 0.f, 0.f, 0.f};
        cur = nxt; cA = nA; cB = nB; ++ui;
        if (wr == 1) PG8_BAR;
    }
    PG8_WAIT_V(0);
    PG8_BAR;
#undef PG8_SA
#undef PG8_SB
#undef PG8_STAGE
#undef PG8_LDA
#undef PG8_LDB
#undef PG8_MMA
#undef PG8_WAIT_V
#undef PG8_WAIT_L
#undef PG8_BAR
#undef PG8_SCHED
}

typedef f32x4 Acc[2][2][4][2];
__device__ __forceinline__ u32x4 pack8(const f32x4& v0, const f32x4& v1) { return cvt8(v0[0], v0[1], v0[2], v0[3], v1[0], v1[1], v1[2], v1[3]); }

struct EpiBf16S {
    bf16_t* O; int ldc; const float* ss; int srow_off;
    __device__ __forceinline__ void operator()(const Acc& acc, const GUnit& u, int wr, int wc, int fr, int fq, int tid) const {
        const int row0 = u.row0 + wr * 64 + fr, col0 = u.col0 + wc * 32 + 8 * fq;
#pragma unroll
        for (int ai = 0; ai < 2; ++ai)
#pragma unroll
            for (int m = 0; m < 4; ++m) { const int row = row0 + ai * HALF + m * 16; bf16_t* rowp = O + (size_t)row * ldc + col0;
                const float rs = ss ? rsqrtf(ss[srow_off + row] * (1.f / DM) + EPS) : 1.f;
#pragma unroll
                for (int bj = 0; bj < 2; ++bj) *(u32x4*)(rowp + bj * HALF) = pack8(acc[ai][bj][m][0] * rs, acc[ai][bj][m][1] * rs); }
    }
};
struct EpiZ {
    bf16_t* Z; float* Zs; const float* ss;
    __device__ __forceinline__ void operator()(const Acc& acc, const GUnit& u, int wr, int wc, int fr, int fq, int tid) const {
        const int row0 = u.row0 + wr * 64 + fr;
        if (u.kind == 0) {
            const int col0 = u.col0 + wc * 32 + 8 * fq;
#pragma unroll
            for (int ai = 0; ai < 2; ++ai)
#pragma unroll
                for (int m = 0; m < 4; ++m) { const int row = row0 + ai * HALF + m * 16; bf16_t* rowp = Z + (size_t)row * NZ + col0;
                    const float rs = rsqrtf(ss[row] * (1.f / DM) + EPS);
#pragma unroll
                    for (int bj = 0; bj < 2; ++bj) *(u32x4*)(rowp + bj * HALF) = pack8(acc[ai][bj][m][0] * rs, acc[ai][bj][m][1] * rs); }
        } else if (wc < 2) {
#pragma unroll
            for (int ai = 0; ai < 2; ++ai)
#pragma unroll
                for (int m = 0; m < 4; ++m) { const int row = row0 + ai * HALF + m * 16; float* p = Zs + (size_t)row * NZS + wc * 32 + 8 * fq;
                    const float rs = rsqrtf(ss[row] * (1.f / DM) + EPS);
                    *(f32x4*)p = acc[ai][0][m][0] * rs; *(f32x4*)(p + 4) = acc[ai][0][m][1] * rs; }
        }
    }
};
struct EpiRes {
    const float* Xin; float* Xout; bf16_t* XG; const float* gnext; float* ss;
    __device__ __forceinline__ void operator()(const Acc& acc, const GUnit& u, int wr, int wc, int fr, int fq, int tid) const {
        const int row0 = u.row0 + wr * 64 + fr, col0 = u.col0 + wc * 32 + 8 * fq;
        f32x4 g[2][2];
#pragma unroll
        for (int bj = 0; bj < 2; ++bj)
#pragma unroll
            for (int n = 0; n < 2; ++n) g[bj][n] = *(const f32x4*)(gnext + col0 + bj * HALF + 4 * n);
#pragma unroll
        for (int ai = 0; ai < 2; ++ai)
#pragma unroll
            for (int m = 0; m < 4; ++m) { const int row = row0 + ai * HALF + m * 16; const size_t off = (size_t)row * DM + col0;
                float sq = 0.f;
#pragma unroll
                for (int bj = 0; bj < 2; ++bj) {
                    const f32x4 v0 = *(const f32x4*)(Xin + off + bj * HALF) + acc[ai][bj][m][0], v1 = *(const f32x4*)(Xin + off + bj * HALF + 4) + acc[ai][bj][m][1];
                    *(f32x4*)(Xout + off + bj * HALF) = v0; *(f32x4*)(Xout + off + bj * HALF + 4) = v1;
                    sq += (v0[0] * v0[0] + v0[1] * v0[1]) + (v0[2] * v0[2] + v0[3] * v0[3]) + (v1[0] * v1[0] + v1[1] * v1[1]) + (v1[2] * v1[2] + v1[3] * v1[3]);
                    *(u32x4*)(XG + off + bj * HALF) = pack8(v0 * g[bj][0], v1 * g[bj][1]);
                }
                sq += __shfl_xor(sq, 16); sq += __shfl_xor(sq, 32);
                if (fq == 0) atomicAdd(ss + row, sq);
            }
    }
};
struct EpiY {
    bf16_t* Y; const float* bg; const float* ss; __amdgpu_buffer_rsrc_t rs;
    __device__ __forceinline__ void operator()(const Acc& acc, const GUnit& u, int wr, int wc, int fr, int fq, int tid) const {
        const int voff = tid * 8;
        if (u.kind == 0) {
            const int br = u.aux;
#pragma unroll
            for (int ai = 0; ai < 2; ++ai)
#pragma unroll
                for (int m = 0; m < 4; ++m)
#pragma unroll
                    for (int bj = 0; bj < 2; ++bj) { const u32x4 w = pack8(acc[ai][bj][m][0], acc[ai][bj][m][1]);
                        const int idx = ((br * 2 + ai) * 4 + m) * 4 + 2 * bj;
                        __builtin_amdgcn_raw_buffer_store_b64((u32x2){w.x, w.y}, rs, voff, idx * 4096, 0); __builtin_amdgcn_raw_buffer_store_b64((u32x2){w.z, w.w}, rs, voff, (idx + 1) * 4096, 0); }
        } else {
            const int j4 = u.aux, row0 = u.row0 + wr * 64 + fr, ycol = u.col0 + 64 * j4 + 16 * wc + 4 * fq;
            f32x4 bia[2][2];
#pragma unroll
            for (int bj = 0; bj < 2; ++bj)
#pragma unroll
                for (int n = 0; n < 2; ++n) bia[bj][n] = *(const f32x4*)(bg + (2 * bj + n) * DM + ycol);
#pragma unroll
            for (int ai = 0; ai < 2; ++ai)
#pragma unroll
                for (int m = 0; m < 4; ++m) {
                    const int row = row0 + ai * HALF + m * 16;
                    const float rn = rsqrtf(ss[row] * (1.f / DM) + EPS);
                    f32x4 y = (f32x4){0.f, 0.f, 0.f, 0.f};
#pragma unroll
                    for (int bj = 0; bj < 2; ++bj)
#pragma unroll
                        for (int n = 0; n < 2; ++n) { const int br = 2 * bj + n;
                            const u32x2 w = __builtin_amdgcn_raw_buffer_load_b64(rs, voff, ((((br * 2 + ai) * 4 + m) * 4) + j4) * 4096, 0);
                            const f32x4 a = acc[ai][bj][m][n] * rn + bia[bj][n];
                            y[0] += sigmoidf_(a[0]) * __uint_as_float(w.x << 16); y[1] += sigmoidf_(a[1]) * __uint_as_float(w.x & 0xffff0000u);
                            y[2] += sigmoidf_(a[2]) * __uint_as_float(w.y << 16); y[3] += sigmoidf_(a[3]) * __uint_as_float(w.y & 0xffff0000u); }
                    u32x2 o; o.x = pk2(y[0], y[1]); o.y = pk2(y[2], y[3]);
                    *(u32x2*)(Y + (size_t)row * DM + ycol) = o;
                    asm volatile("" ::: "memory");
                }
        }
    }
};

struct EpiUp {
    bf16_t* ACT; const float* ss; const float* cw; const float* cb; float* stash; LAS unsigned char* ul;
    __device__ __forceinline__ static int uoff(int row, int chunk) { return row * 256 + ((chunk ^ (row & 15)) << 4); }
    __device__ __forceinline__ static void ld8(LAS unsigned char* p, float (&f)[8]) { const u32x4 t = *(const LAS u32x4*)p; unpack8(t, f); }
    __device__ __forceinline__ void operator()(const Acc& acc, const GUnit& u, int wr, int wc, int fr, int fq, int tid) const {
        asm volatile("" : "+v"(fr), "+v"(fq));
        const int j = u.col0 >> 8, pmg = u.row0 >> 8, chunk = 4 * wc + fq, cbase = 128 * j + 32 * wc + 8 * fq;
        float* st = stash + ((size_t)(pmg * 22 + j) * 6) * 128 + 32 * wc + 8 * fq;
        float h1[8], h2[8];
#pragma unroll
        for (int e = 0; e < 8; ++e) { h1[e] = 0.f; h2[e] = 0.f; }
#pragma unroll
        for (int ai = 0; ai < 2; ++ai) {
            float rsr[4];
#pragma unroll
            for (int m = 0; m < 4; ++m) { const int r = 64 * wr + 16 * m + fr;
                rsr[m] = rsqrtf(ss[u.row0 + ai * HALF + r] * (1.f / DM) + EPS);
                *(LAS u32x4*)(ul + uoff(r, chunk)) = pack8(acc[ai][0][m][0] * rsr[m], acc[ai][0][m][1] * rsr[m]); }
            asm volatile("s_waitcnt lgkmcnt(0)" ::: "memory"); __builtin_amdgcn_s_barrier(); asm volatile("" ::: "memory");
#pragma unroll
            for (int m = 0; m < 4; ++m) { const int r = 64 * wr + 16 * m + fr;
                float cu[8], p1[8], p2[8];
                ld8(ul + uoff(r, chunk), cu); ld8(ul + uoff((r - 1) & 127, chunk), p1); ld8(ul + uoff((r - 2) & 127, chunk), p2);
                if (ai == 1 && r == 0) {
#pragma unroll
                    for (int e = 0; e < 8; ++e) { p1[e] = h1[e]; p2[e] = h2[e]; } }
                if (ai == 1 && r == 1) {
#pragma unroll
                    for (int e = 0; e < 8; ++e) p2[e] = h1[e]; }
                const f32x4 v0 = acc[ai][1][m][0] * rsr[m], v1 = acc[ai][1][m][1] * rsr[m];
                float o[8];
#pragma unroll
                for (int hh = 0; hh < 2; ++hh) {
                    const f32x4 a0 = *(const f32x4*)(cw + cbase + 4 * hh), a1 = *(const f32x4*)(cw + DFF + cbase + 4 * hh), a2 = *(const f32x4*)(cw + 2 * DFF + cbase + 4 * hh), bq = *(const f32x4*)(cb + cbase + 4 * hh);
#pragma unroll
                    for (int e = 0; e < 4; ++e) { const float x = a0[e] * p2[4 * hh + e] + a1[e] * p1[4 * hh + e] + a2[e] * cu[4 * hh + e] + bq[e]; o[4 * hh + e] = gelu_tanh(x) * (hh ? v1[e] : v0[e]); } }
                *(u32x4*)(ACT + (size_t)(u.row0 + ai * HALF + r) * DFF + cbase) = cvt8(o[0], o[1], o[2], o[3], o[4], o[5], o[6], o[7]);
                if (ai == 0 && r < 2) {
                    *(f32x4*)(st + r * 128) = (f32x4){cu[0], cu[1], cu[2], cu[3]}; *(f32x4*)(st + r * 128 + 4) = (f32x4){cu[4], cu[5], cu[6], cu[7]};
                    *(f32x4*)(st + (4 + r) * 128) = v0; *(f32x4*)(st + (4 + r) * 128 + 4) = v1; }
                if (ai == 1 && r >= 126) {
                    *(f32x4*)(st + (r - 124) * 128) = (f32x4){cu[0], cu[1], cu[2], cu[3]}; *(f32x4*)(st + (r - 124) * 128 + 4) = (f32x4){cu[4], cu[5], cu[6], cu[7]}; }
                asm volatile("" ::: "memory");
            }
            if (ai == 0) { ld8(ul + uoff(127, chunk), h1); ld8(ul + uoff(126, chunk), h2); }
            asm volatile("s_waitcnt lgkmcnt(0)" ::: "memory"); __builtin_amdgcn_s_barrier(); asm volatile("" ::: "memory");
        }
    }
};

struct SchedPanel {
    const char* A; const char* B; int ld, nt, nN, pm, row0, pn0;
    __device__ __forceinline__ bool next(int i, GUnit& u) const {
        if (i >= nN) return false;
        const int pn = pn0 + i;
        u.A = A + (size_t)pm * 256 * ld * 2; u.B = B + (size_t)pn * 256 * ld * 2; u.nt = nt; u.kind = 0; u.row0 = row0; u.col0 = pn * 256; u.aux = 0; return true;
    }
};
struct SchedZ {
    const char* A; const char* B; int pm;
    __device__ __forceinline__ bool next(int i, GUnit& u) const {
        if (i >= 13) return false;
        u.A = A + (size_t)pm * 256 * DM * 2; u.B = B + (size_t)i * 256 * DM * 2; u.nt = 16; u.kind = (i == 12) ? 1 : 0; u.row0 = pm * 256; u.col0 = i * 256; u.aux = 0; return true;
    }
};
struct SchedY {
    const char* H; const char* O; const char* WbT; const char* WgT; int pm;
    __device__ __forceinline__ bool next(int i, GUnit& u) const {
        if (i >= 32) return false;
        const int pn = i >> 3, br = (i >> 1) & 3, kind = i & 1;
        u.kind = kind; u.aux = br; u.row0 = pm * 256; u.col0 = pn * 256;
        if (kind == 0) { u.A = O + (size_t)pm * 256 * DM * 2 + br * 256 * 2; u.B = WbT + (size_t)pn * 256 * DM * 2 + br * 256 * 2; u.nt = 4; }
        else { u.A = H + (size_t)pm * 256 * DM * 2; u.B = WgT + (size_t)(br * 1024 + pn * 256) * DM * 2; u.nt = 16; }
        return true;
    }
};
struct SchedG {
    const char* A; const char* B; int ld, nt, nN, np, gp, a_panel0, o_panel0, xcd, w, lastkind;
    __device__ __forceinline__ bool next(int i, GUnit& u) const {
        const int idx = i * 32 + w;
        if (idx >= np * nN) return false;
        const int q = idx / (gp * nN), v = idx % (gp * nN), ntile = v / gp, pl = xcd * np + q * gp + v % gp;
        u.A = A + (size_t)(a_panel0 + pl) * 256 * ld * 2; u.B = B + (size_t)ntile * 256 * ld * 2; u.nt = nt;
        u.kind = (lastkind && ntile == nN - 1) ? 1 : 0; u.row0 = (o_panel0 + pl) * 256; u.col0 = ntile * 256; u.aux = 0; return true;
    }
};
struct SchedY2 {
    const char* H; const char* O; const char* WbT; const char* WgT; int xcd, w;
    __device__ __forceinline__ bool next(int i, GUnit& u) const {
        if (i >= 32) return false;
        const int pm = xcd * 32 + (i >> 3) * 8 + (w & 7), pn = w >> 3, kind = (i >> 2) & 1, idx = i & 3;
        u.kind = kind; u.aux = idx; u.row0 = pm * 256; u.col0 = pn * 256;
        if (kind == 0) { u.A = O + (size_t)pm * 256 * DM * 2 + idx * 256 * 2; u.B = WbT + (size_t)pn * 256 * DM * 2 + idx * 256 * 2; u.nt = 4; }
        else { u.A = H + (size_t)pm * 256 * DM * 2; u.B = WgT + (size_t)((pn * 4 + idx) * 256) * DM * 2; u.nt = 16; }
        return true;
    }
};
struct SchedOne {
    const char* A; const char* B; int nt, row0, col0;
    __device__ __forceinline__ bool next(int i, GUnit& u) const {
        if (i >= 1) return false;
        u.A = A; u.B = B; u.nt = nt; u.kind = 0; u.row0 = row0; u.col0 = col0; u.aux = 0; return true;
    }
};
}

__device__ __forceinline__ int srccol(int map, int r) {
    if (map == 0) return r;
    if (map == 1) {
        if (r < 1024) return r;
        if (r < 1792) return r + 16;
        if (r < 3072) return r + 24;
        if (r < 3088) return 1024 + (r - 3072);
        if (r < 3096) return 1808 + (r - 3088);
        if (r < 3108) return r;
        return -1;
    }
    if (map == 2) {
        const int j = r >> 8, w = r & 255;
        return w < 128 ? 128 * j + w : DFF + 128 * j + (w - 128); }
    const int c = r & 255, bj = c >> 7, wc = (c >> 5) & 3, fq = (c >> 3) & 3, n = (c >> 2) & 1, e = c & 3;
    if (map == 4) return (r & ~255) + 64 * (2 * bj + n) + 16 * wc + 4 * fq + e;
    const int unit = r >> 8, pn = unit >> 2, j4 = unit & 3;
    return (2 * bj + n) * (DM * DM) + 256 * pn + 64 * j4 + 16 * wc + 4 * fq + e;
}
__device__ __forceinline__ void tr_item(const float* W, int ldw, bf16_t* WT, int ldd, int dk0, int map, int r_off, int nkb, int item, LAS float* scr, int lane) {
    const int rb = item / nkb, kb = item % nkb, k0 = 32 * kb, r0 = 64 * rb;
    const int g = lane & 15, kq = lane >> 4;
    const int sc = srccol(map, r_off + r0 + 4 * g);
#pragma unroll
    for (int i = 0; i < 8; ++i) { const int kk = 4 * i + kq;
        const f32x4 v = sc >= 0 ? *(const f32x4*)(W + (size_t)(k0 + kk) * ldw + sc) : (f32x4){0.f, 0.f, 0.f, 0.f};
        scr[kk * 65 + 4 * g] = v[0]; scr[kk * 65 + 4 * g + 1] = v[1]; scr[kk * 65 + 4 * g + 2] = v[2]; scr[kk * 65 + 4 * g + 3] = v[3]; }
    LDS_FENCE();
    bf16_t* dp = WT + (size_t)(r0 + lane) * ldd + dk0 + k0;
#pragma unroll
    for (int c = 0; c < 4; ++c) { const LAS float* sp = scr + (8 * c) * 65 + lane;
        *(u32x4*)(dp + 8 * c) = cvt8(sp[0], sp[65], sp[2 * 65], sp[3 * 65], sp[4 * 65], sp[5 * 65], sp[6 * 65], sp[7 * 65]); }
    LDS_FENCE();
}
struct Args { const float* in[31]; float* out; unsigned char* ws; int ph_lo, ph_hi, use_bar, rep_gemm, rep_mix, rep_mem; };
struct TrJob { const float* W; int ldw; bf16_t* WT; int ldd, dk0, map, nkb, nitems, r_off; };
__device__ __forceinline__ TrJob tr_job(const Args& args, unsigned char* ws, int l, int j) {
    unsigned char* wb = ws + WS_W + (size_t)l * W_STRIDE;
    TrJob q; q.dk0 = 0; q.map = 0; q.r_off = 0;
    if (j == 0) { q.W = args.in[3] + (size_t)l * DM * 3108; q.ldw = 3108; q.WT = (bf16_t*)(wb + WO_IN); q.ldd = DM; q.map = 1; q.nkb = 32; q.nitems = (NWIN / 64) * 32; }
    else if (j < 5) { const int i = j - 1; q.W = args.in[17] + (size_t)l * 4 * DM * DM; q.ldw = DM; q.WT = (bf16_t*)(wb + WO_G) + (size_t)i * DM * DM; q.ldd = DM; q.map = 3; q.nkb = 32; q.nitems = 16 * 32; q.r_off = i * 1024; }
    else if (j < 9) { const int i = j - 5; q.W = args.in[16] + ((size_t)l * 4 + i) * 256 * DM; q.ldw = DM; q.WT = (bf16_t*)(wb + WO_B); q.ldd = DM; q.dk0 = 256 * i; q.map = 4; q.nkb = 8; q.nitems = 16 * 8; }
    else if (j == 9) { q.W = args.in[19] + (size_t)l * DM * DM; q.ldw = DM; q.WT = (bf16_t*)(wb + WO_OUT); q.ldd = DM; q.nkb = 32; q.nitems = 16 * 32; }
    else if (j == 10) { q.W = args.in[22] + (size_t)l * DM * 512; q.ldw = 512; q.WT = (bf16_t*)(wb + WO_XQ); q.ldd = DM; q.nkb = 32; q.nitems = 8 * 32; }
    else if (j == 11) { q.W = args.in[23] + (size_t)l * DM * DM; q.ldw = DM; q.WT = (bf16_t*)(wb + WO_KV); q.ldd = DM; q.nkb = 32; q.nitems = 16 * 32; }
    else if (j == 12) { q.W = args.in[24] + (size_t)l * 512 * DM; q.ldw = DM; q.WT = (bf16_t*)(wb + WO_XO); q.ldd = 512; q.nkb = 16; q.nitems = 16 * 16; }
    else if (j == 13) { q.W = args.in[26] + (size_t)l * DM * NUP; q.ldw = NUP; q.WT = (bf16_t*)(wb + WO_UP); q.ldd = DM; q.map = 2; q.nkb = 32; q.nitems = (NUP / 64) * 32; }
    else if (j == 14) { q.W = args.in[29] + (size_t)l * DFF * DM; q.ldw = DM; q.WT = (bf16_t*)(wb + WO_DN); q.ldd = DFF; q.nkb = 88; q.nitems = 16 * 88; }
    else { const int kv = (j - 15) >> 1, hf = (j - 15) & 1;
        q.W = args.in[14] + ((size_t)l * 2 + kv) * 2048 * 64 + (size_t)hf * 1024 * 64; q.ldw = 64; q.WT = (bf16_t*)(wb + WO_C1) + ((size_t)kv * 128 + hf * 64) * 1024; q.ldd = 1024; q.nkb = 32; q.nitems = 1 * 32; }
    return q;
}

__device__ __forceinline__ void rms_row_bf16(const float* xrow, const float* g, bf16_t* orow, int lane) {
    const f32x4* xr = (const f32x4*)xrow + lane; const f32x4* gr = (const f32x4*)g + lane;
    f32x4 v[4]; float s = 0.f;
#pragma unroll
    for (int j = 0; j < 4; ++j) { v[j] = xr[64 * j]; s += (v[j].x * v[j].x + v[j].y * v[j].y) + (v[j].z * v[j].z + v[j].w * v[j].w); }
    const float rs = rsqrtf(wave_sum(s) * (1.f / DM) + EPS);
    unsigned long long* o8 = (unsigned long long*)orow + lane;
#pragma unroll
    for (int j = 0; j < 4; ++j) { const f32x4 gg = gr[64 * j];
        o8[64 * j] = (unsigned long long)pk2(v[j].x * rs * gg.x, v[j].y * rs * gg.y) | ((unsigned long long)pk2(v[j].z * rs * gg.z, v[j].w * rs * gg.w) << 32); }
}
__device__ __forceinline__ void xg_row_bf16(const float* xrow, const float* g, bf16_t* orow, float* ssq, int lane) {
    const f32x4* xr = (const f32x4*)xrow + lane; const f32x4* gr = (const f32x4*)g + lane;
    f32x4 v[4]; float s = 0.f;
#pragma unroll
    for (int j = 0; j < 4; ++j) { v[j] = xr[64 * j]; s += (v[j].x * v[j].x + v[j].y * v[j].y) + (v[j].z * v[j].z + v[j].w * v[j].w); }
    s = wave_sum(s);
    if (lane == 0) *ssq = s;
    unsigned long long* o8 = (unsigned long long*)orow + lane;
#pragma unroll
    for (int j = 0; j < 4; ++j) { const f32x4 gg = gr[64 * j];
        o8[64 * j] = (unsigned long long)pk2(v[j].x * gg.x, v[j].y * gg.y) | ((unsigned long long)pk2(v[j].z * gg.z, v[j].w * gg.w) << 32); }
}
__device__ __forceinline__ void rms_row_f32(float* xrow, const float* g, int lane) {
    f32x4* xr = (f32x4*)xrow + lane; const f32x4* gr = (const f32x4*)g + lane;
    f32x4 v[4]; float s = 0.f;
#pragma unroll
    for (int j = 0; j < 4; ++j) { v[j] = xr[64 * j]; s += (v[j].x * v[j].x + v[j].y * v[j].y) + (v[j].z * v[j].z + v[j].w * v[j].w); }
    const float rs = rsqrtf(wave_sum(s) * (1.f / DM) + EPS);
#pragma unroll
    for (int j = 0; j < 4; ++j) { const f32x4 gg = gr[64 * j]; xr[64 * j] = v[j] * rs * gg; }
}

__device__ __forceinline__ void tr64(const bf16_t* src, int lds_, bf16_t* dst, int ldd, LAS bf16_t* tile, int lane) {
    const u32x4* sp = (const u32x4*)(src + (size_t)lane * lds_);
#pragma unroll
    for (int c = 0; c < 8; ++c) { const u32x4 w = sp[c];
        tile[(8 * c + 0) * 72 + lane] = (bf16_t)(w.x & 0xffff); tile[(8 * c + 1) * 72 + lane] = (bf16_t)(w.x >> 16);
        tile[(8 * c + 2) * 72 + lane] = (bf16_t)(w.y & 0xffff); tile[(8 * c + 3) * 72 + lane] = (bf16_t)(w.y >> 16);
        tile[(8 * c + 4) * 72 + lane] = (bf16_t)(w.z & 0xffff); tile[(8 * c + 5) * 72 + lane] = (bf16_t)(w.z >> 16);
        tile[(8 * c + 6) * 72 + lane] = (bf16_t)(w.w & 0xffff); tile[(8 * c + 7) * 72 + lane] = (bf16_t)(w.w >> 16); }
    LDS_FENCE();
    u32x4* dp = (u32x4*)(dst + (size_t)lane * ldd);
#pragma unroll
    for (int c = 0; c < 8; ++c) dp[c] = *(const LAS u32x4*)(tile + lane * 72 + 8 * c);
    LDS_FENCE();
}

__device__ __forceinline__ void pool_item(const bf16_t* Z, bf16_t* O, const float* pw, const float* pscale, LAS float* wl, int b, int g, int t0, int lane) {
    asm volatile("" : "+v"(lane));
    float W[64];
#pragma unroll
    for (int c = 0; c < 64; ++c) W[c] = pw[(g * 64 + c) * 64 + lane];
    const float scale = pscale[g * 64 + lane];
    const int w = 2 << g;
    float hst[15];
#pragma unroll
    for (int k = 0; k < 15; ++k) { const int tt = t0 - 1 - k; hst[k] = tt >= 0 ? bf2f(Z[(size_t)(b * SEQ + tt) * NZ + ZC_POOL + g * 64 + lane]) : 0.f; }
    bf16_t n8[8];
#pragma unroll
    for (int i = 0; i < 8; ++i) n8[i] = Z[(size_t)(b * SEQ + t0 + i) * NZ + ZC_POOL + g * 64 + lane];
    for (int tb = 0; tb < 8; ++tb) {
        int rowi = b * SEQ + t0 + tb * 8; asm volatile("" : "+s"(rowi));
        float u8[8];
#pragma unroll
        for (int i = 0; i < 8; ++i) u8[i] = bf2f(n8[i]);
        if (tb < 7) {
#pragma unroll
            for (int i = 0; i < 8; ++i) n8[i] = Z[(size_t)(rowi + 8 + i) * NZ + ZC_POOL + g * 64 + lane]; }
#pragma unroll
        for (int i = 0; i < 8; ++i) {
            const int t = t0 + tb * 8 + i;
            const float u0 = u8[i];
            float sum = u0;
#pragma unroll
            for (int k = 0; k < 15; ++k) sum += (k + 1 < w) ? hst[k] : 0.f;
            const int cnt = (t + 1) < w ? (t + 1) : w;
            const float d = sum / (float)cnt - u0;
            wl[i * 64 + lane] = d;
#pragma unroll
            for (int k = 14; k > 0; --k) hst[k] = hst[k - 1];
            hst[0] = u0;
        }
        LDS_FENCE();
#pragma unroll 1
        for (int i = 0; i < 8; ++i) {
            float o = 0.f;
#pragma unroll
            for (int c = 0; c < 16; ++c) { const f32x4 d4 = *(const LAS f32x4*)(wl + i * 64 + 4 * c); o += d4[0] * W[4 * c] + d4[1] * W[4 * c + 1] + d4[2] * W[4 * c + 2] + d4[3] * W[4 * c + 3]; }
            O[(size_t)(rowi + i) * DM + g * 64 + lane] = (bf16_t)f2bf(o * scale);
        }
        LDS_FENCE();
    }
}

struct GlaRaw { float lr[2], q[4], k[4], v[8], r[8]; };
template <int MODE>
__device__ __forceinline__ void gla_load(GlaRaw& t, const bf16_t* Z, const float* Zs, int row0i, int h, int lane) {
    asm volatile("" : "+s"(row0i));
    const size_t row0 = (size_t)row0i;
#pragma unroll
    for (int rp = 0; rp < 2; ++rp) t.lr[rp] = Zs[(row0 + rp * 4 + (lane >> 4)) * NZS + ZS_LR + (lane & 15)];
#pragma unroll
    for (int rp = 0; rp < 4; ++rp) { const bf16_t* zr = Z + (row0 + rp * 2 + (lane >> 5)) * NZ; t.q[rp] = bf2f(zr[ZC_AQ + h * 32 + (lane & 31)]); t.k[rp] = bf2f(zr[ZC_AK + h * 32 + (lane & 31)]); }
#pragma unroll
    for (int i = 0; i < 8; ++i) { const bf16_t* zr = Z + (row0 + i) * NZ; t.v[i] = bf2f(zr[ZC_AV + h * 64 + lane]); t.r[i] = (MODE == 3) ? bf2f(zr[ZC_AR + h * 64 + lane]) : 0.f; }
}
template <int MODE>
__device__ __forceinline__ void gla_chunk(const bf16_t* Z, const float* Zs, bf16_t* O, const float* w_lr, const float* b_lr, const float* gnorm,
                                          float* Sbuf, float* Dbuf, LAS float* wl, int b, int h, int n, int lane) {
    asm volatile("" : "+v"(lane));
    float wlr[16];
#pragma unroll
    for (int j = 0; j < 16; ++j) wlr[j] = w_lr[j * 128 + h * 32 + (lane & 31)];
    const float bl = b_lr[h * 32 + (lane & 31)], gn = gnorm[lane];
    const size_t chunk = ((size_t)b * 4 + h) * 32 + n;
    float S[32];
#pragma unroll
    for (int d = 0; d < 32; ++d) S[d] = (MODE == 3) ? Sbuf[chunk * 2048 + d * 64 + lane] : 0.f;
    float Dc = 1.f;
    GlaRaw t;
    gla_load<MODE>(t, Z, Zs, b * SEQ + n * 64, h, lane);
    for (int sb = 0; sb < 8; ++sb) {
        int row0i = b * SEQ + n * 64 + sb * 8; asm volatile("" : "+s"(row0i)); const size_t row0 = (size_t)row0i;
#pragma unroll
        for (int rp = 0; rp < 2; ++rp) wl[rp * 64 + lane] = t.lr[rp];
#pragma unroll
        for (int rp = 0; rp < 4; ++rp) { wl[128 + rp * 64 + lane] = t.q[rp] * 0.17677669529663687f; wl[384 + rp * 64 + lane] = t.k[rp]; }
#pragma unroll
        for (int i = 0; i < 8; ++i) { wl[896 + i * 64 + lane] = t.v[i]; if (MODE == 3) wl[1408 + i * 64 + lane] = t.r[i]; }
        if (sb < 7) gla_load<MODE>(t, Z, Zs, row0i + 8, h, lane);
        LDS_FENCE();
#pragma unroll
        for (int rp = 0; rp < 4; ++rp) {
            const int tok = rp * 2 + (lane >> 5);
            float x = bl;
#pragma unroll
            for (int c = 0; c < 4; ++c) { const f32x4 l4 = *(const LAS f32x4*)(wl + tok * 16 + 4 * c); x += l4[0] * wlr[4 * c] + l4[1] * wlr[4 * c + 1] + l4[2] * wlr[4 * c + 2] + l4[3] * wlr[4 * c + 3]; }
            const float ls = fminf(x, 0.f) - log1pf(__expf(-fabsf(x)));
            const float e = __expf(ls * (1.0f / 16.0f));
            Dc *= e;
            wl[640 + tok * 32 + (lane & 31)] = e;
        }
        LDS_FENCE();
#pragma unroll 2
        for (int i = 0; i < 8; ++i) {
            const float vi = wl[896 + i * 64 + lane];
            f32x4 o4 = (f32x4){0.f, 0.f, 0.f, 0.f};
#pragma unroll
            for (int c = 0; c < 8; ++c) {
                const f32x4 e4 = *(const LAS f32x4*)(wl + 640 + i * 32 + 4 * c), k4 = *(const LAS f32x4*)(wl + 384 + i * 32 + 4 * c);
#pragma unroll
                for (int j = 0; j < 4; ++j) S[4 * c + j] = S[4 * c + j] * e4[j] + k4[j] * vi;
                if (MODE == 3) { const f32x4 q4 = *(const LAS f32x4*)(wl + 128 + i * 32 + 4 * c);
#pragma unroll
                    for (int j = 0; j < 4; ++j) o4[j] += q4[j] * S[4 * c + j]; }
            }
            if (MODE == 3) wl[1920 + i * 64 + lane] = (o4[0] + o4[1]) + (o4[2] + o4[3]);
        }
        LDS_FENCE();
        if (MODE == 3) {
#pragma unroll
            for (int i = 0; i < 8; ++i) { const float o = wl[1920 + i * 64 + lane];
                const float rn = rsqrtf(wave_sum(o * o) * (1.f / 64.f) + EPS);
                O[(row0 + i) * DM + 256 + h * 64 + lane] = (bf16_t)f2bf(o * rn * gn * siluf_(wl[1408 + i * 64 + lane])); }
            LDS_FENCE();
        }
    }
    if (MODE == 1) {
#pragma unroll
        for (int d = 0; d < 32; ++d) Sbuf[chunk * 2048 + d * 64 + lane] = S[d];
        Dc *= __shfl_xor(Dc, 32);
        if (lane < 32) Dbuf[chunk * 32 + lane] = Dc;
    }
}
__device__ __forceinline__ void gla_scan(float* Sbuf, const float* Dbuf, int bh, int lane) {
    float S[32];
#pragma unroll
    for (int d = 0; d < 32; ++d) S[d] = 0.f;
    for (int n = 0; n < 32; ++n) {
        const size_t chunk = (size_t)bh * 32 + n;
        float Sl[32];
#pragma unroll
        for (int d = 0; d < 32; ++d) Sl[d] = Sbuf[chunk * 2048 + d * 64 + lane];
        float Dn[32];
#pragma unroll
        for (int d = 0; d < 32; ++d) Dn[d] = Dbuf[chunk * 32 + d];
#pragma unroll
        for (int d = 0; d < 32; ++d) { Sbuf[chunk * 2048 + d * 64 + lane] = S[d]; S[d] = Dn[d] * S[d] + Sl[d]; }
    }
}

struct GdnRaw { float k[8], v[8], q[8], g[8], ab; };
template <int MODE>
__device__ __forceinline__ void gdn_load(GdnRaw& t, const bf16_t* Z, const float* Zs, int row0i, int h, int lane) {
    asm volatile("" : "+s"(row0i));
    const size_t row0 = (size_t)row0i;
#pragma unroll
    for (int i = 0; i < 8; ++i) { const bf16_t* zr = Z + (row0 + i) * NZ;
        t.k[i] = bf2f(zr[ZC_DK + h * 64 + lane]); t.v[i] = bf2f(zr[ZC_DV + h * 64 + lane]);
        t.q[i] = (MODE == 3) ? bf2f(zr[ZC_DQ + h * 64 + lane]) : 0.f; t.g[i] = (MODE == 3) ? bf2f(zr[ZC_DG + h * 64 + lane]) : 0.f; }
    t.ab = Zs[(row0 + (lane & 7)) * NZS + ((lane & 8) ? ZS_DB : ZS_DA) + h];
}
template <int MODE>
__device__ __forceinline__ void gdn_chunk(const bf16_t* Z, const float* Zs, bf16_t* O, const float* convw, const float* a_log, const float* dt_bias, const float* gnorm,
                                          float* Sbuf, float* Pbuf, LAS float* wl, int b, int h, int n, int lane) {
    asm volatile("" : "+v"(lane));
    float cq[4], ck[4], cv[4];
#pragma unroll
    for (int i = 0; i < 4; ++i) { cq[i] = convw[i * 768 + h * 64 + lane]; ck[i] = convw[i * 768 + 256 + h * 64 + lane]; cv[i] = convw[i * 768 + 512 + h * 64 + lane]; }
    const float Aneg = -__expf(a_log[h]), dtb = dt_bias[h], gn = gnorm[lane];
    const size_t chunk = ((size_t)b * 4 + h) * 32 + n;
    const size_t rowc = (size_t)b * SEQ + n * 64;
    float q1 = 0.f, q2 = 0.f, q3 = 0.f, k1 = 0.f, k2 = 0.f, k3 = 0.f, v1 = 0.f, v2 = 0.f, v3 = 0.f;
    if (n > 0) { const bf16_t* z1 = Z + (rowc - 1) * NZ; const bf16_t* z2 = Z + (rowc - 2) * NZ; const bf16_t* z3 = Z + (rowc - 3) * NZ;
        k1 = bf2f(z1[ZC_DK + h * 64 + lane]); k2 = bf2f(z2[ZC_DK + h * 64 + lane]); k3 = bf2f(z3[ZC_DK + h * 64 + lane]);
        v1 = bf2f(z1[ZC_DV + h * 64 + lane]); v2 = bf2f(z2[ZC_DV + h * 64 + lane]); v3 = bf2f(z3[ZC_DV + h * 64 + lane]);
        if (MODE == 3) { q1 = bf2f(z1[ZC_DQ + h * 64 + lane]); q2 = bf2f(z2[ZC_DQ + h * 64 + lane]); q3 = bf2f(z3[ZC_DQ + h * 64 + lane]); } }
    float S[64], Phi[MODE == 1 ? 64 : 1];
#pragma unroll
    for (int d = 0; d < 64; ++d) S[d] = (MODE == 3) ? Sbuf[chunk * 4096 + d * 64 + lane] : 0.f;
    if (MODE == 1) {
#pragma unroll
        for (int d = 0; d < 64; ++d) Phi[MODE == 1 ? d : 0] = (d == lane) ? 1.f : 0.f; }
    GdnRaw t;
    gdn_load<MODE>(t, Z, Zs, (int)rowc, h, lane);
    for (int sb = 0; sb < 8; ++sb) {
        int row0i = (int)rowc + sb * 8; asm volatile("" : "+s"(row0i)); const size_t row0 = (size_t)row0i;
#pragma unroll
        for (int i = 0; i < 8; ++i) { wl[i * 64 + lane] = t.k[i]; wl[1024 + i * 64 + lane] = t.v[i]; if (MODE == 3) { wl[512 + i * 64 + lane] = t.q[i]; wl[1536 + i * 64 + lane] = t.g[i]; } }
        if (lane < 8) wl[2048 + lane] = __expf(Aneg * softplusf_(t.ab + dtb)); else if (lane < 16) wl[2048 + lane] = sigmoidf_(t.ab);
        if (sb < 7) gdn_load<MODE>(t, Z, Zs, row0i + 8, h, lane);
        LDS_FENCE();
#pragma unroll 2
        for (int i = 0; i < 8; ++i) {
            const float rk = wl[i * 64 + lane], rv = wl[1024 + i * 64 + lane];
            float xk = ck[0] * k3 + ck[1] * k2 + ck[2] * k1 + ck[3] * rk;
            const float xw = cv[0] * v3 + cv[1] * v2 + cv[2] * v1 + cv[3] * rv;
            k3 = k2; k2 = k1; k1 = rk; v3 = v2; v2 = v1; v1 = rv;
            xk = siluf_(xk);
            wl[i * 64 + lane] = xk * rsqrtf(wave_sum(xk * xk) + EPS);
            wl[1024 + i * 64 + lane] = siluf_(xw);
            if (MODE == 3) { const float rq = wl[512 + i * 64 + lane]; float xq = cq[0] * q3 + cq[1] * q2 + cq[2] * q1 + cq[3] * rq; q3 = q2; q2 = q1; q1 = rq; xq = siluf_(xq);
                wl[512 + i * 64 + lane] = xq * rsqrtf(wave_sum(xq * xq) + EPS) * 0.125f; }
        }
        LDS_FENCE();
#pragma unroll 1
        for (int i = 0; i < 8; ++i) {
            const float a = wl[2048 + i], bcf = wl[2056 + i], xvi = wl[1024 + i * 64 + lane];
            typedef float f32x2 __attribute__((ext_vector_type(2)));
            if (MODE == 3) {
                f32x4 kk[16];
#pragma unroll
                for (int c = 0; c < 16; ++c) kk[c] = *(const LAS f32x4*)(wl + i * 64 + 4 * c);
                f32x2 ks0 = (f32x2){0.f, 0.f}, ks1 = (f32x2){0.f, 0.f};
#pragma unroll
                for (int c = 0; c < 16; ++c) { ks0 += (f32x2){kk[c][0], kk[c][1]} * (f32x2){S[4 * c], S[4 * c + 1]}; ks1 += (f32x2){kk[c][2], kk[c][3]} * (f32x2){S[4 * c + 2], S[4 * c + 3]}; }
                const float kS = (ks0[0] + ks0[1]) + (ks1[0] + ks1[1]);
                const float vn = bcf * (xvi - a * kS);
                const f32x2 a2 = (f32x2){a, a}, v2 = (f32x2){vn, vn};
                f32x2 o0 = (f32x2){0.f, 0.f}, o1 = (f32x2){0.f, 0.f};
#pragma unroll
                for (int c = 0; c < 16; ++c) {
                    const f32x4 q4 = *(const LAS f32x4*)(wl + 512 + i * 64 + 4 * c);
                    f32x2 s0 = a2 * (f32x2){S[4 * c], S[4 * c + 1]} + (f32x2){kk[c][0], kk[c][1]} * v2, s1 = a2 * (f32x2){S[4 * c + 2], S[4 * c + 3]} + (f32x2){kk[c][2], kk[c][3]} * v2;
                    S[4 * c] = s0[0]; S[4 * c + 1] = s0[1]; S[4 * c + 2] = s1[0]; S[4 * c + 3] = s1[1];
                    o0 += (f32x2){q4[0], q4[1]} * s0; o1 += (f32x2){q4[2], q4[3]} * s1;
                    if ((c & 3) == 3) asm volatile("" ::: "memory");
                }
                wl[512 + i * 64 + lane] = (o0[0] + o0[1]) + (o1[0] + o1[1]);
            } else {
                float kSa = 0.f, kSb = 0.f, kPa = 0.f, kPb = 0.f;
#pragma unroll
                for (int c = 0; c < 16; ++c) { const f32x4 k4 = *(const LAS f32x4*)(wl + i * 64 + 4 * c);
                    kSa += k4[0] * S[4 * c]; kSb += k4[1] * S[4 * c + 1]; kSa += k4[2] * S[4 * c + 2]; kSb += k4[3] * S[4 * c + 3];
                    kPa += k4[0] * Phi[MODE == 1 ? 4 * c : 0]; kPb += k4[1] * Phi[MODE == 1 ? 4 * c + 1 : 0]; kPa += k4[2] * Phi[MODE == 1 ? 4 * c + 2 : 0]; kPb += k4[3] * Phi[MODE == 1 ? 4 * c + 3 : 0]; }
                const float kS = kSa + kSb, kP = kPa + kPb;
                const float vn = bcf * (xvi - a * kS), vp = -bcf * a * kP;
#pragma unroll
                for (int c = 0; c < 16; ++c) { const f32x4 k4 = *(const LAS f32x4*)(wl + i * 64 + 4 * c);
#pragma unroll
                    for (int j = 0; j < 4; ++j) { S[4 * c + j] = a * S[4 * c + j] + k4[j] * vn; Phi[MODE == 1 ? 4 * c + j : 0] = a * Phi[MODE == 1 ? 4 * c + j : 0] + k4[j] * vp; }
                    if ((c & 3) == 3) asm volatile("" ::: "memory");
                }
            }
        }
        LDS_FENCE();
        if (MODE == 3) {
#pragma unroll 2
            for (int i = 0; i < 8; ++i) { const float o = wl[512 + i * 64 + lane];
                const float rn = rsqrtf(wave_sum(o * o) * (1.f / 64.f) + EPS);
                O[(row0 + i) * DM + 512 + h * 64 + lane] = (bf16_t)f2bf(o * rn * gn * siluf_(wl[1536 + i * 64 + lane])); }
            LDS_FENCE();
        }
    }
    if (MODE == 1) {
#pragma unroll
        for (int d = 0; d < 64; ++d) { Sbuf[chunk * 4096 + d * 64 + lane] = S[d]; Pbuf[chunk * 4096 + d * 64 + lane] = Phi[MODE == 1 ? d : 0]; }
    }
}
__device__ __forceinline__ void gdn_scan_wg(float* Sbuf, const float* Pbuf, LAS float* wl, int bh, int wave, int lane) {
    float S[64];
#pragma unroll
    for (int d = 0; d < 64; ++d) S[d] = 0.f;
    const int d0 = 8 * wave;
    f32x4 pn[2]; float sl[8];
    { const size_t chunk = (size_t)bh * 32;
      const f32x4* pp = (const f32x4*)(Pbuf + chunk * 4096 + d0 * 64);
      pn[0] = pp[lane]; pn[1] = pp[64 + lane];
#pragma unroll
      for (int i = 0; i < 8; ++i) sl[i] = Sbuf[chunk * 4096 + (d0 + i) * 64 + lane]; }
    for (int n = 0; n < 32; ++n) {
        const size_t chunk = (size_t)bh * 32 + n;
        *(LAS f32x4*)(wl + wave * 512 + lane * 4) = pn[0]; *(LAS f32x4*)(wl + wave * 512 + 256 + lane * 4) = pn[1];
        float sc_[8];
#pragma unroll
        for (int i = 0; i < 8; ++i) { sc_[i] = sl[i]; Sbuf[chunk * 4096 + (d0 + i) * 64 + lane] = (n == 0) ? 0.f : wl[4096 + (d0 + i) * 64 + lane]; }
        if (n + 1 < 32) {
            const f32x4* pp = (const f32x4*)(Pbuf + (chunk + 1) * 4096 + d0 * 64);
            pn[0] = pp[lane]; pn[1] = pp[64 + lane];
#pragma unroll
            for (int i = 0; i < 8; ++i) sl[i] = Sbuf[(chunk + 1) * 4096 + (d0 + i) * 64 + lane];
        }
        LDS_FENCE();
#pragma unroll
        for (int i = 0; i < 8; ++i) {
            float acc = sc_[i];
#pragma unroll
            for (int c = 0; c < 16; ++c) { const f32x4 p4 = *(const LAS f32x4*)(wl + wave * 512 + i * 64 + 4 * c);
                acc += p4[0] * S[4 * c] + p4[1] * S[4 * c + 1] + p4[2] * S[4 * c + 2] + p4[3] * S[4 * c + 3]; }
            wl[4096 + (d0 + i) * 64 + lane] = acc;
        }
        LDS_FENCE();
        __syncthreads();
#pragma unroll
        for (int d = 0; d < 64; ++d) S[d] = wl[4096 + d * 64 + lane];
        LDS_FENCE();
        __syncthreads();
    }
}

typedef short s16x4 __attribute__((ext_vector_type(4)));
__device__ __forceinline__ f32x4 mfma16x32(bf16x8 a, bf16x8 b, f32x4 c) { return __builtin_amdgcn_mfma_f32_16x16x32_bf16(a, b, c, 0, 0, 0); }
__device__ __forceinline__ f32x4 mfma16x16(s16x4 a, s16x4 b, f32x4 c) { return __builtin_amdgcn_mfma_f32_16x16x16bf16_1k(a, b, c, 0, 0, 0); }
__device__ __forceinline__ s16x4 cvt4(float a0, float a1, float a2, float a3) {
    u32x2 p;
    asm("s_nop 11\n\tv_cvt_pk_bf16_f32 %0, %2, %3\n\tv_cvt_pk_bf16_f32 %1, %4, %5\n\ts_nop 1" : "=&v"(p[0]), "=&v"(p[1]) : "v"(a0), "v"(a1), "v"(a2), "v"(a3));
    return __builtin_bit_cast(s16x4, p);
}
__device__ __forceinline__ float row16_sum(float v) { DPP_ADD_(v, 0xB1, 0xf); DPP_ADD_(v, 0x4E, 0xf); DPP_ADD_(v, 0x141, 0xf); DPP_ADD_(v, 0x140, 0xf); return v; }
__device__ __forceinline__ float row16_scan(float v) {
    v += __int_as_float(__builtin_amdgcn_update_dpp(0, __float_as_int(v), 0x111, 0xf, 0xf, true));
    v += __int_as_float(__builtin_amdgcn_update_dpp(0, __float_as_int(v), 0x112, 0xf, 0xf, true));
    v += __int_as_float(__builtin_amdgcn_update_dpp(0, __float_as_int(v), 0x114, 0xf, 0xf, true));
    v += __int_as_float(__builtin_amdgcn_update_dpp(0, __float_as_int(v), 0x118, 0xf, 0xf, true));
    return v;
}

__device__ __forceinline__ void gdn_prep(const bf16_t* Z, const float* Zs, const float* convw, const float* a_log, const float* dt_bias,
                                         bf16_t* KT, bf16_t* QN, bf16_t* KN, bf16_t* XVT, float* AB, int b, int h, int n, int lane) {
    asm volatile("" : "+v"(lane));
    float cq[4], ck[4], cv[4];
#pragma unroll
    for (int i = 0; i < 4; ++i) { cq[i] = convw[i * 768 + h * 64 + lane]; ck[i] = convw[i * 768 + 256 + h * 64 + lane]; cv[i] = convw[i * 768 + 512 + h * 64 + lane]; }
    const float Aneg = -__expf(a_log[h]), dtb = dt_bias[h];
    const size_t rowc = (size_t)b * SEQ + n * 64;
    float q1 = 0.f, q2 = 0.f, q3 = 0.f, k1 = 0.f, k2 = 0.f, k3 = 0.f, v1 = 0.f, v2 = 0.f, v3 = 0.f;
    if (n > 0) { const bf16_t* z1 = Z + (rowc - 1) * NZ; const bf16_t* z2 = Z + (rowc - 2) * NZ; const bf16_t* z3 = Z + (rowc - 3) * NZ;
        k1 = bf2f(z1[ZC_DK + h * 64 + lane]); k2 = bf2f(z2[ZC_DK + h * 64 + lane]); k3 = bf2f(z3[ZC_DK + h * 64 + lane]);
        v1 = bf2f(z1[ZC_DV + h * 64 + lane]); v2 = bf2f(z2[ZC_DV + h * 64 + lane]); v3 = bf2f(z3[ZC_DV + h * 64 + lane]);
        q1 = bf2f(z1[ZC_DQ + h * 64 + lane]); q2 = bf2f(z2[ZC_DQ + h * 64 + lane]); q3 = bf2f(z3[ZC_DQ + h * 64 + lane]); }
    const size_t trow = (((size_t)b * 4 + h) * 64 + lane) * SEQ + n * 64;
    bf16_t nk[8], nv[8], nq[8]; float nab;
    { const size_t row0 = rowc;
#pragma unroll
      for (int i = 0; i < 8; ++i) { const bf16_t* zr = Z + (row0 + i) * NZ; nk[i] = zr[ZC_DK + h * 64 + lane]; nv[i] = zr[ZC_DV + h * 64 + lane]; nq[i] = zr[ZC_DQ + h * 64 + lane]; }
      nab = Zs[(row0 + (lane & 7)) * NZS + ((lane & 8) ? ZS_DB : ZS_DA) + h]; }
    for (int sb = 0; sb < 8; ++sb) {
        int row0i = (int)rowc + sb * 8; asm volatile("" : "+s"(row0i)); const size_t row0 = (size_t)row0i;
        float rk[8], rv[8], rq[8];
#pragma unroll
        for (int i = 0; i < 8; ++i) { rk[i] = bf2f(nk[i]); rv[i] = bf2f(nv[i]); rq[i] = bf2f(nq[i]); }
        const float ab = nab;
        if (sb < 7) { const size_t rown = row0 + 8;
#pragma unroll
            for (int i = 0; i < 8; ++i) { const bf16_t* zr = Z + (rown + i) * NZ; nk[i] = zr[ZC_DK + h * 64 + lane]; nv[i] = zr[ZC_DV + h * 64 + lane]; nq[i] = zr[ZC_DQ + h * 64 + lane]; }
            nab = Zs[(rown + (lane & 7)) * NZS + ((lane & 8) ? ZS_DB : ZS_DA) + h]; }
        float kk[8], qq[8], vv[8];
#pragma unroll
        for (int i = 0; i < 8; ++i) {
            float xk = ck[0] * k3 + ck[1] * k2 + ck[2] * k1 + ck[3] * rk[i];
            float xq = cq[0] * q3 + cq[1] * q2 + cq[2] * q1 + cq[3] * rq[i];
            const float xw = cv[0] * v3 + cv[1] * v2 + cv[2] * v1 + cv[3] * rv[i];
            k3 = k2; k2 = k1; k1 = rk[i]; q3 = q2; q2 = q1; q1 = rq[i]; v3 = v2; v2 = v1; v1 = rv[i];
            xk = siluf_(xk); xq = siluf_(xq);
            kk[i] = xk * rsqrtf(wave_sum(xk * xk) + EPS);
            qq[i] = xq * rsqrtf(wave_sum(xq * xq) + EPS) * 0.125f;
            vv[i] = siluf_(xw);
            KN[(row0 + i) * 256 + h * 64 + lane] = (bf16_t)f2bf(kk[i]); QN[(row0 + i) * 256 + h * 64 + lane] = (bf16_t)f2bf(qq[i]);
        }
        *(u32x4*)(KT + trow + sb * 8) = cvt8(kk[0], kk[1], kk[2], kk[3], kk[4], kk[5], kk[6], kk[7]);
        *(u32x4*)(XVT + trow + sb * 8) = cvt8(vv[0], vv[1], vv[2], vv[3], vv[4], vv[5], vv[6], vv[7]);
        if (lane < 8) AB[((row0 + lane) * 4 + h) * 2] = Aneg * softplusf_(ab + dtb);
        else if (lane < 16) AB[((row0 + lane - 8) * 4 + h) * 2 + 1] = sigmoidf_(ab);
    }
}

__device__ __forceinline__ void gdn_dma(LAS unsigned char* buf, const bf16_t* Z, const bf16_t* KT, const bf16_t* QN, const bf16_t* KN, const bf16_t* XVT, int b, int h, int blk, int lane) {
    asm volatile("" : "+s"(blk), "+v"(lane));
    const int c = lane & 15, qd = lane >> 4, bh = b * 4 + h;
    const size_t row0 = (size_t)b * SEQ + blk * 16;
    const bf16_t* kr = KN + (row0 + c) * 256 + h * 64; const bf16_t* qr = QN + (row0 + c) * 256 + h * 64;
#define GDMA(piece, gptr) __builtin_amdgcn_global_load_lds((const unsigned*)(gptr), (LAS unsigned*)(buf + (piece) * 1024), 16, 0, 0)
    GDMA(0, kr + 8 * qd); GDMA(1, kr + 32 + 8 * qd); GDMA(2, qr + 8 * qd); GDMA(3, qr + 32 + 8 * qd);
    GDMA(4, qr + 4 * qd); GDMA(5, qr + 16 + 4 * qd); GDMA(6, qr + 32 + 4 * qd); GDMA(7, qr + 48 + 4 * qd);
#pragma unroll
    for (int rt = 0; rt < 4; ++rt) GDMA(8 + rt, KT + ((size_t)bh * 64 + 16 * rt + c) * SEQ + blk * 16 + 4 * qd);
    GDMA(12, XVT + ((size_t)bh * 64 + lane) * SEQ + blk * 16); GDMA(13, XVT + ((size_t)bh * 64 + lane) * SEQ + blk * 16 + 8);
    GDMA(14, Z + (row0 + (lane >> 3)) * NZ + ZC_DG + h * 64 + 8 * (lane & 7)); GDMA(15, Z + (row0 + 8 + (lane >> 3)) * NZ + ZC_DG + h * 64 + 8 * (lane & 7));
#undef GDMA
}

#ifndef GDN_HILO
#define GDN_HILO 0
#endif
__device__ __forceinline__ float bf_res(float x) { return x - __uint_as_float(__float_as_uint(x) & 0xffff0000u) ; }
__device__ __forceinline__ unsigned pk_trunc(float lo, float hi) { return (__float_as_uint(lo) >> 16) | (__float_as_uint(hi) & 0xffff0000u); }
__device__ __forceinline__ void gdn_seq(const bf16_t* Z, const bf16_t* KT, const bf16_t* QN, const bf16_t* KN, const bf16_t* XVT, const float* AB, const float* gnorm, bf16_t* O,
                                        LAS unsigned char* bufA, LAS unsigned char* bufB, LAS unsigned char* wk, int b, int h, int lane) {
    const int c = lane & 15, qd = lane >> 4;
    LAS float* Lm = (LAS float*)wk; LAS bf16_t* Wl = (LAS bf16_t*)(wk + 1024); LAS float* Ul = (LAS float*)(wk + 3072);
    LAS float* Ee = (LAS float*)(wk + 7168); LAS float* Eb = (LAS float*)(wk + 7232); LAS float* Eg = (LAS float*)(wk + 7296); LAS bf16_t* Wl2 = (LAS bf16_t*)(wk + 7424);
    f32x4 Sacc[4][4];
#pragma unroll
    for (int rt = 0; rt < 4; ++rt)
#pragma unroll
        for (int ct = 0; ct < 4; ++ct) Sacc[rt][ct] = (f32x4){0.f, 0.f, 0.f, 0.f};
    float gn[4];
#pragma unroll
    for (int ct = 0; ct < 4; ++ct) gn[ct] = gnorm[16 * ct + c];
    gdn_dma(bufA, Z, KT, QN, KN, XVT, b, h, 0, lane);
    float g_n = AB[(((size_t)b * SEQ + c) * 4 + h) * 2], beta_n = AB[(((size_t)b * SEQ + c) * 4 + h) * 2 + 1];
    unsigned outp[8];
#pragma unroll
    for (int i = 0; i < 8; ++i) outp[i] = 0u;
    for (int blk = 0; blk < SEQ / 16; ++blk) {
        LAS unsigned char* buf = (blk & 1) ? bufB : bufA;
        const size_t row0 = (size_t)b * SEQ + blk * 16;
        asm volatile("s_waitcnt vmcnt(0)" ::: "memory");
        const float g_t = g_n, beta_t = beta_n;
        if (blk > 0) {
#pragma unroll
            for (int jj = 0; jj < 4; ++jj)
#pragma unroll
                for (int ct = 0; ct < 4; ++ct) { const unsigned w = outp[jj * 2 + (ct >> 1)]; O[(row0 - 16 + 4 * qd + jj) * DM + 512 + h * 64 + 16 * ct + c] = (bf16_t)((ct & 1) ? (w >> 16) : (w & 0xffff)); } }
        if (blk + 1 < SEQ / 16) { gdn_dma((blk & 1) ? bufA : bufB, Z, KT, QN, KN, XVT, b, h, blk + 1, lane);
            g_n = AB[((row0 + 16 + c) * 4 + h) * 2]; beta_n = AB[((row0 + 16 + c) * 4 + h) * 2 + 1]; }
        const float gc = row16_scan(g_t), e_t = __expf(gc);
        const float glast = rdlane(gc, 15), elast = __expf(glast);
        if (lane < 16) { Ee[lane] = e_t; Eb[lane] = beta_t; Eg[lane] = gc; }
        const bf16x8 kf0 = *(const LAS bf16x8*)(buf + 0 * 1024 + lane * 16), kf1 = *(const LAS bf16x8*)(buf + 1 * 1024 + lane * 16);
        const bf16x8 qf0 = *(const LAS bf16x8*)(buf + 2 * 1024 + lane * 16), qf1 = *(const LAS bf16x8*)(buf + 3 * 1024 + lane * 16);
        f32x4 G = (f32x4){0.f, 0.f, 0.f, 0.f}, KQ = (f32x4){0.f, 0.f, 0.f, 0.f};
        G = mfma16x32(kf0, kf0, G); G = mfma16x32(kf1, kf1, G);
        KQ = mfma16x32(kf0, qf0, KQ); KQ = mfma16x32(kf1, qf1, KQ);
        LDS_FENCE();
        float aqv[4], gr4[4], Lv[4];
#pragma unroll
        for (int jj = 0; jj < 4; ++jj) gr4[jj] = Eg[4 * qd + jj];
#pragma unroll
        for (int jj = 0; jj < 4; ++jj) { const int i = 4 * qd + jj;
            Lv[jj] = (c < i) ? Eb[i] * G[jj] * __expf(gr4[jj] - gc) : 0.f;
            aqv[jj] = (i <= c) ? KQ[jj] * __expf(gc - gr4[jj]) : 0.f; }
        const s16x4 aqf = cvt4(aqv[0], aqv[1], aqv[2], aqv[3]);
        LDS_FENCE();
        {
            float xv[16], xu[16], kn[16], xw[16];
            { const u32x4 a = *(const LAS u32x4*)(buf + 12 * 1024 + lane * 16), bq = *(const LAS u32x4*)(buf + 13 * 1024 + lane * 16);
              float t8[8]; unpack8(a, t8);
#pragma unroll
              for (int i = 0; i < 8; ++i) xv[i] = t8[i];
              unpack8(bq, t8);
#pragma unroll
              for (int i = 0; i < 8; ++i) xv[8 + i] = t8[i]; }
            { const int rt = lane >> 4;
#pragma unroll
              for (int q4 = 0; q4 < 4; ++q4) { const u32x2 t2 = *(const LAS u32x2*)(buf + (8 + rt) * 1024 + (q4 * 16 + c) * 16);
                  kn[4 * q4] = bf2f(t2.x & 0xffff); kn[4 * q4 + 1] = bf2f(t2.x >> 16); kn[4 * q4 + 2] = bf2f(t2.y & 0xffff); kn[4 * q4 + 3] = bf2f(t2.y >> 16); } }
            const float be_t = beta_t * e_t;
#pragma unroll
            for (int i = 0; i < 16; ++i) { xu[i] = rdlane(beta_t, i) * xv[i]; xw[i] = rdlane(be_t, i) * kn[i]; }
#pragma unroll
            for (int j = 0; j < 16; ++j) {
#pragma unroll
                for (int i = j + 1; i < 16; ++i) { const float lij = rdlane(Lv[i & 3], (i >> 2) * 16 + j); xu[i] -= lij * xu[j]; xw[i] -= lij * xw[j]; }
                Ul[j * 64 + lane] = xu[j];
                const float nw = -xw[j];
                if (GDN_HILO) { Wl[j * 64 + lane] = (bf16_t)(__float_as_uint(nw) >> 16); Wl2[j * 64 + lane] = (bf16_t)f2bf(bf_res(nw)); } else Wl[j * 64 + lane] = (bf16_t)f2bf(nw);
            }
        }
        LDS_FENCE();
        bf16x8 wfa[2], wfb[2], qfa[2];
#pragma unroll
        for (int ks = 0; ks < 2; ++ks) {
            const u32x2 w0 = *(const LAS u32x2*)(Wl + c * 64 + 32 * ks + 4 * qd), w1 = *(const LAS u32x2*)(Wl + c * 64 + 32 * ks + 16 + 4 * qd);
            wfa[ks] = __builtin_bit_cast(bf16x8, (u32x4){w0.x, w0.y, w1.x, w1.y});
            const u32x2 w2 = *(const LAS u32x2*)(Wl2 + c * 64 + 32 * ks + 4 * qd), w3 = *(const LAS u32x2*)(Wl2 + c * 64 + 32 * ks + 16 + 4 * qd);
            wfb[ks] = __builtin_bit_cast(bf16x8, (u32x4){w2.x, w2.y, w3.x, w3.y});
            const u32x2 q0 = *(const LAS u32x2*)(buf + (4 + 2 * ks) * 1024 + lane * 16), q1_ = *(const LAS u32x2*)(buf + (5 + 2 * ks) * 1024 + lane * 16);
            qfa[ks] = __builtin_bit_cast(bf16x8, (u32x4){q0.x, q0.y, q1_.x, q1_.y});
        }
        float e4[4], sc4[4];
#pragma unroll
        for (int jj = 0; jj < 4; ++jj) { e4[jj] = Ee[4 * qd + jj]; sc4[jj] = __expf(glast - gr4[jj]); }
        f32x4 oacc[4]; s16x4 vsb[4], vsb2[4];
#pragma unroll
        for (int ct = 0; ct < 4; ++ct) {
            f32x4 vn;
#pragma unroll
            for (int jj = 0; jj < 4; ++jj) vn[jj] = Ul[(4 * qd + jj) * 64 + 16 * ct + c];
            f32x4 qs = (f32x4){0.f, 0.f, 0.f, 0.f};
#pragma unroll
            for (int ks = 0; ks < 2; ++ks) {
                const f32x4 lo = Sacc[2 * ks][ct], hi = Sacc[2 * ks + 1][ct];
                const bf16x8 sb = GDN_HILO ? __builtin_bit_cast(bf16x8, (u32x4){pk_trunc(lo[0], lo[1]), pk_trunc(lo[2], lo[3]), pk_trunc(hi[0], hi[1]), pk_trunc(hi[2], hi[3])})
                                           : __builtin_bit_cast(bf16x8, cvt8(lo[0], lo[1], lo[2], lo[3], hi[0], hi[1], hi[2], hi[3]));
                const bf16x8 sb2 = __builtin_bit_cast(bf16x8, cvt8(bf_res(lo[0]), bf_res(lo[1]), bf_res(lo[2]), bf_res(lo[3]), bf_res(hi[0]), bf_res(hi[1]), bf_res(hi[2]), bf_res(hi[3])));
                if (GDN_HILO) { vn = mfma16x32(wfa[ks], sb, vn); vn = mfma16x32(wfa[ks], sb2, vn); vn = mfma16x32(wfb[ks], sb, vn);
                                qs = mfma16x32(qfa[ks], sb, qs); qs = mfma16x32(qfa[ks], sb2, qs); }
                else { vn = mfma16x32(wfa[ks], sb, vn); qs = mfma16x32(qfa[ks], sb, qs); } }
#pragma unroll
            for (int jj = 0; jj < 4; ++jj) qs[jj] *= e4[jj];
            oacc[ct] = mfma16x16(aqf, cvt4(vn[0], vn[1], vn[2], vn[3]), qs);
            const float s0 = vn[0] * sc4[0], s1 = vn[1] * sc4[1], s2 = vn[2] * sc4[2], s3 = vn[3] * sc4[3];
            vsb[ct] = GDN_HILO ? __builtin_bit_cast(s16x4, (u32x2){pk_trunc(s0, s1), pk_trunc(s2, s3)}) : __builtin_bit_cast(s16x4, (u32x2){pk2(s0, s1), pk2(s2, s3)});
            vsb2[ct] = cvt4(bf_res(s0), bf_res(s1), bf_res(s2), bf_res(s3));
            asm volatile("" ::: "memory");
        }
#pragma unroll
        for (int rt = 0; rt < 4; ++rt) {
            const u32x2 k2 = *(const LAS u32x2*)(buf + (8 + rt) * 1024 + lane * 16);
            const s16x4 ktf = __builtin_bit_cast(s16x4, k2);
#pragma unroll
            for (int ct = 0; ct < 4; ++ct) { f32x4 t = mfma16x16(ktf, vsb[ct], Sacc[rt][ct] * elast); Sacc[rt][ct] = GDN_HILO ? mfma16x16(ktf, vsb2[ct], t) : t; }
        }
#pragma unroll
        for (int jj = 0; jj < 4; ++jj) {
            float ss = 0.f;
#pragma unroll
            for (int ct = 0; ct < 4; ++ct) ss += oacc[ct][jj] * oacc[ct][jj];
            const float rn = rsqrtf(row16_sum(ss) * (1.f / 64.f) + EPS);
            const int tok = 4 * qd + jj;
            float ov[4];
#pragma unroll
            for (int ct = 0; ct < 4; ++ct) { const float gt = bf2f(*(const LAS bf16_t*)(buf + 14 * 1024 + tok * 128 + (16 * ct + c) * 2)); ov[ct] = oacc[ct][jj] * rn * gn[ct] * gt * __builtin_amdgcn_rcpf(1.0f + __expf(-gt)); }
            outp[jj * 2] = pk2(ov[0], ov[1]); outp[jj * 2 + 1] = pk2(ov[2], ov[3]);
        }
        LDS_FENCE();
    }
    { const size_t row0 = (size_t)b * SEQ + SEQ;
#pragma unroll
      for (int jj = 0; jj < 4; ++jj)
#pragma unroll
          for (int ct = 0; ct < 4; ++ct) { const unsigned w = outp[jj * 2 + (ct >> 1)]; O[(row0 - 16 + 4 * qd + jj) * DM + 512 + h * 64 + 16 * ct + c] = (bf16_t)((ct & 1) ? (w >> 16) : (w & 0xffff)); } }
}

__device__ __forceinline__ void gla_prep(const bf16_t* Z, const float* Zs, const float* w_lr, const float* b_lr, bf16_t* KUT, bf16_t* QE, bf16_t* KE, float* DEC,
                                         int b, int h, int n, int lane) {
    asm volatile("" : "+v"(lane));
    const int d = lane & 31, half = lane >> 5;
    float wlr[16];
#pragma unroll
    for (int j = 0; j < 16; ++j) wlr[j] = w_lr[j * 128 + h * 32 + d];
    const float bl = b_lr[h * 32 + d];
    for (int bi = 0; bi < 2; ++bi) {
        int blk = n * 4 + half + 2 * bi;
        const size_t row0 = (size_t)b * SEQ + blk * 16;
        float kk[16], bcv[16];
        float bc = 0.f;
#pragma unroll
        for (int i = 0; i < 16; ++i) {
            const float* lr = Zs + (row0 + i) * NZS + ZS_LR;
            const f32x4 l0 = *(const f32x4*)lr, l1 = *(const f32x4*)(lr + 4), l2 = *(const f32x4*)(lr + 8), l3 = *(const f32x4*)(lr + 12);
            float x = bl;
#pragma unroll
            for (int e = 0; e < 4; ++e) x += l0[e] * wlr[e] + l1[e] * wlr[4 + e] + l2[e] * wlr[8 + e] + l3[e] * wlr[12 + e];
            const float ls = fminf(x, 0.f) - log1pf(__expf(-fabsf(x)));
            bc += ls * (1.0f / 16.0f);
            const bf16_t* zr = Z + (row0 + i) * NZ;
            const float q = bf2f(zr[ZC_AQ + h * 32 + d]) * 0.17677669529663687f, k = bf2f(zr[ZC_AK + h * 32 + d]);
            kk[i] = k; bcv[i] = bc;
            QE[(row0 + i) * 128 + h * 32 + d] = (bf16_t)f2bf(q * __expf(bc)); KE[(row0 + i) * 128 + h * 32 + d] = (bf16_t)f2bf(k * __expf(-bc));
        }
        float ku[16];
#pragma unroll
        for (int i = 0; i < 16; ++i) ku[i] = kk[i] * __expf(bc - bcv[i]);
        bf16_t* kr = KUT + (((size_t)b * 4 + h) * 32 + d) * SEQ + blk * 16;
        *(u32x4*)kr = cvt8(ku[0], ku[1], ku[2], ku[3], ku[4], ku[5], ku[6], ku[7]); *(u32x4*)(kr + 8) = cvt8(ku[8], ku[9], ku[10], ku[11], ku[12], ku[13], ku[14], ku[15]);
        DEC[(((size_t)b * (SEQ / 16) + blk) * 4 + h) * 32 + d] = __expf(bc);
    }
}
struct GlaOps { u32x4 qe, ke, v0, v1, r0, r1; u32x2 qa0, qa1, ku0, ku1; };
__device__ __forceinline__ void gla_fetch(GlaOps& t, const bf16_t* Z, const bf16_t* KUT, const bf16_t* QE, const bf16_t* KE, int b, int h, int blk, int lane) {
    asm volatile("" : "+v"(lane));
    const int c = lane & 15, qd = lane >> 4, bh = b * 4 + h;
    const size_t row0 = (size_t)b * SEQ + blk * 16;
    const bf16_t* qr = QE + (row0 + c) * 128 + h * 32; const bf16_t* kr = KE + (row0 + c) * 128 + h * 32;
    t.qe = *(const u32x4*)(qr + 8 * qd); t.ke = *(const u32x4*)(kr + 8 * qd);
    t.qa0 = *(const u32x2*)(qr + 4 * qd); t.qa1 = *(const u32x2*)(qr + 16 + 4 * qd);
    t.ku0 = *(const u32x2*)(KUT + ((size_t)bh * 32 + c) * SEQ + blk * 16 + 4 * qd); t.ku1 = *(const u32x2*)(KUT + ((size_t)bh * 32 + 16 + c) * SEQ + blk * 16 + 4 * qd);
    const bf16_t* zv = Z + (row0 + (lane >> 3)) * NZ + h * 64 + 8 * (lane & 7);
    t.v0 = *(const u32x4*)(zv + ZC_AV); t.v1 = *(const u32x4*)(zv + 8 * NZ + ZC_AV); t.r0 = *(const u32x4*)(zv + ZC_AR); t.r1 = *(const u32x4*)(zv + 8 * NZ + ZC_AR);
}
__device__ __forceinline__ void gla_seq(const bf16_t* Z, const bf16_t* KUT, const bf16_t* QE, const bf16_t* KE, const float* DEC, const float* gnorm, bf16_t* O,
                                        LAS unsigned char* buf, int b, int h, int lane) {
    const int c = lane & 15, qd = lane >> 4;
    f32x4 Sacc[2][4];
#pragma unroll
    for (int rt = 0; rt < 2; ++rt)
#pragma unroll
        for (int ct = 0; ct < 4; ++ct) Sacc[rt][ct] = (f32x4){0.f, 0.f, 0.f, 0.f};
    float gn[4];
#pragma unroll
    for (int ct = 0; ct < 4; ++ct) gn[ct] = gnorm[16 * ct + c];
    GlaOps t;
    gla_fetch(t, Z, KUT, QE, KE, b, h, 0, lane);
    const float* dp = DEC + (((size_t)b * (SEQ / 16)) * 4 + h) * 32 + 4 * qd;
    f32x4 dn0 = *(const f32x4*)dp, dn1 = *(const f32x4*)(dp + 16);
    for (int blk = 0; blk < SEQ / 16; ++blk) {
        const size_t row0 = (size_t)b * SEQ + blk * 16;
        *(LAS u32x4*)(buf + lane * 16) = t.v0; *(LAS u32x4*)(buf + 1024 + lane * 16) = t.v1; *(LAS u32x4*)(buf + 2048 + lane * 16) = t.r0; *(LAS u32x4*)(buf + 3072 + lane * 16) = t.r1;
        const bf16x8 qef = __builtin_bit_cast(bf16x8, t.qe), kef = __builtin_bit_cast(bf16x8, t.ke);
        const bf16x8 qea = __builtin_bit_cast(bf16x8, (u32x4){t.qa0.x, t.qa0.y, t.qa1.x, t.qa1.y});
        const s16x4 kuf0 = __builtin_bit_cast(s16x4, t.ku0), kuf1 = __builtin_bit_cast(s16x4, t.ku1);
        const f32x4 d0 = dn0, d1 = dn1;
        if (blk + 1 < SEQ / 16) { gla_fetch(t, Z, KUT, QE, KE, b, h, blk + 1, lane);
            dn0 = *(const f32x4*)(dp + (size_t)(blk + 1) * 128); dn1 = *(const f32x4*)(dp + (size_t)(blk + 1) * 128 + 16); }
        LDS_FENCE();
        f32x4 att = mfma16x32(kef, qef, (f32x4){0.f, 0.f, 0.f, 0.f});
        const s16x4 attf = cvt4((4 * qd + 0 <= c) ? att[0] : 0.f, (4 * qd + 1 <= c) ? att[1] : 0.f, (4 * qd + 2 <= c) ? att[2] : 0.f, (4 * qd + 3 <= c) ? att[3] : 0.f);
        f32x4 oacc[4]; s16x4 vb[4];
#pragma unroll
        for (int ct = 0; ct < 4; ++ct) {
            const f32x4 lo = Sacc[0][ct], hi = Sacc[1][ct];
            const bf16x8 sb = __builtin_bit_cast(bf16x8, cvt8(lo[0], lo[1], lo[2], lo[3], hi[0], hi[1], hi[2], hi[3]));
            f32x4 qs = mfma16x32(qea, sb, (f32x4){0.f, 0.f, 0.f, 0.f});
            asm volatile("s_nop 15\n\ts_nop 7" : "+v"(qs));
            unsigned short v4[4];
#pragma unroll
            for (int jj = 0; jj < 4; ++jj) v4[jj] = *(const LAS bf16_t*)(buf + (4 * qd + jj) * 128 + (16 * ct + c) * 2);
            vb[ct] = __builtin_bit_cast(s16x4, (u32x2){(unsigned)v4[0] | ((unsigned)v4[1] << 16), (unsigned)v4[2] | ((unsigned)v4[3] << 16)});
            oacc[ct] = mfma16x16(attf, vb[ct], qs);
        }
#pragma unroll
        for (int ct = 0; ct < 4; ++ct) { Sacc[0][ct] = mfma16x16(kuf0, vb[ct], Sacc[0][ct] * d0); Sacc[1][ct] = mfma16x16(kuf1, vb[ct], Sacc[1][ct] * d1); }
#pragma unroll
        for (int jj = 0; jj < 4; ++jj) {
            float ss = 0.f;
#pragma unroll
            for (int ct = 0; ct < 4; ++ct) ss += oacc[ct][jj] * oacc[ct][jj];
            const float rn = rsqrtf(row16_sum(ss) * (1.f / 64.f) + EPS);
            const int tok = 4 * qd + jj;
#pragma unroll
            for (int ct = 0; ct < 4; ++ct) { const float gt = bf2f(*(const LAS bf16_t*)(buf + 2048 + tok * 128 + (16 * ct + c) * 2));
                O[(row0 + tok) * DM + 256 + h * 64 + 16 * ct + c] = (bf16_t)f2bf(oacc[ct][jj] * rn * gn[ct] * gt * __builtin_amdgcn_rcpf(1.0f + __expf(-gt))); }
        }
        LDS_FENCE();
    }
}

__device__ __forceinline__ void cmp1_item(const bf16_t* Z, const bf16_t* Wc1T, float* PH, int kv, int b, int g, int mg, int lane) {
    const int rw = lane & 15, quad = lane >> 4;
    const int m = 16 * mg + rw;
    const bf16_t* zb = Z + (size_t)(b * SEQ + 16 * m) * NZ + (kv ? ZC_NVC : ZC_NKC) + g * 64 + 8 * quad;
    const bf16_t* wb = Wc1T + (size_t)kv * 128 * 1024 + (size_t)rw * 1024 + 8 * quad;
    f32x4 acc[8];
#pragma unroll
    for (int n = 0; n < 8; ++n) acc[n] = (f32x4){0.f, 0.f, 0.f, 0.f};
    for (int ks = 0; ks < 32; ++ks) {
        const bf16x8 a = *(const bf16x8*)(zb + (size_t)(ks >> 1) * NZ + 32 * (ks & 1));
#pragma unroll
        for (int n = 0; n < 8; ++n) { const bf16x8 bb = *(const bf16x8*)(wb + (size_t)(16 * n) * 1024 + 32 * ks); acc[n] = __builtin_amdgcn_mfma_f32_16x16x32_bf16(a, bb, acc[n], 0, 0, 0); }
    }
#pragma unroll
    for (int n = 0; n < 8; ++n)
#pragma unroll
        for (int j = 0; j < 4; ++j) { const int mm = 16 * mg + 4 * quad + j; PH[((((size_t)b * 128 + mm) * 2 + g) * 2 + kv) * 128 + 16 * n + rw] = acc[n][j]; }
}
__device__ __forceinline__ void cmp2_item(const float* PH, const float* C0P, const float* w2, bf16_t* CK, bf16_t* CVT, LAS float* wl, int kv, int b, int g, int n, int lane) {
    if (n == 127) { if (kv == 0) CK[(((size_t)b * 2 + g) * 128 + 127) * 64 + lane] = 0; else CVT[(((size_t)b * 2 + g) * 64 + lane) * 128 + 127] = 0; return; }
    float hid = PH[((((size_t)b * 128 + n) * 2 + g) * 2 + kv) * 128 + lane] + PH[((((size_t)b * 128 + n + 1) * 2 + g) * 2 + kv) * 128 + 64 + lane];
#pragma unroll
    for (int s = 0; s < 8; ++s) hid += C0P[(kv * 8 + s) * 64 + lane];
    wl[lane] = gelu_tanh(hid);
    LDS_FENCE();
    float o = 0.f;
#pragma unroll
    for (int c = 0; c < 16; ++c) { const f32x4 a4 = *(const LAS f32x4*)(wl + 4 * c);
#pragma unroll
        for (int j = 0; j < 4; ++j) o += a4[j] * w2[(kv * 64 + 4 * c + j) * 64 + lane]; }
    LDS_FENCE();
    if (kv == 0) CK[(((size_t)b * 2 + g) * 128 + n) * 64 + lane] = (bf16_t)f2bf(o);
    else CVT[(((size_t)b * 2 + g) * 64 + lane) * 128 + n] = (bf16_t)f2bf(o);
}

__device__ __forceinline__ f32x16 mfma32(bf16x8 a, bf16x8 b, f32x16 c) { return __builtin_amdgcn_mfma_f32_32x32x16_bf16(a, b, c, 0, 0, 0); }
__device__ __forceinline__ bf16x8 pack8f(const float* p) { return __builtin_bit_cast(bf16x8, cvt8(p[0], p[1], p[2], p[3], p[4], p[5], p[6], p[7])); }
template <int D>
__device__ __forceinline__ f32x16 qk_tile(const bf16_t* Kp, int ldk, int key0, const bf16x8 (&qf)[D / 16], int r, int h) {
    const int prow = (r & 19) | ((r & 4) << 1) | ((r & 8) >> 1);
    const bf16_t* kp = Kp + (size_t)(key0 + prow) * ldk + 8 * h;
    f32x16 s;
#pragma unroll
    for (int i = 0; i < 16; ++i) s[i] = 0.f;
#pragma unroll
    for (int k = 0; k < D / 16; ++k) s = mfma32(*(const bf16x8*)(kp + 16 * k), qf[k], s);
    return s;
}
template <int D>
__device__ __forceinline__ void pv_tile(const float* p, f32x16 (&o)[D / 32], const bf16_t* VTp, int ldv, int key0, int r, int h) {
#pragma unroll
    for (int s = 0; s < 2; ++s) { const bf16x8 pb = pack8f(p + 8 * s);
#pragma unroll
        for (int dt = 0; dt < D / 32; ++dt) o[dt] = mfma32(*(const bf16x8*)(VTp + (size_t)(32 * dt + r) * ldv + key0 + 16 * s + 8 * h), pb, o[dt]); }
}
template <int D>
__device__ __forceinline__ void load_k(const bf16_t* Kp, int ldk, int key0, int r, int h, bf16x8 (&kf)[D / 16]) {
    const int prow = (r & 19) | ((r & 4) << 1) | ((r & 8) >> 1);
    const bf16_t* kp = Kp + (size_t)(key0 + prow) * ldk + 8 * h;
#pragma unroll
    for (int k = 0; k < D / 16; ++k) kf[k] = *(const bf16x8*)(kp + 16 * k);
}
template <int D>
__device__ __forceinline__ void load_v(const bf16_t* VTp, int ldv, int key0, int r, int h, bf16x8 (&vf)[2][D / 32]) {
#pragma unroll
    for (int s = 0; s < 2; ++s)
#pragma unroll
        for (int dt = 0; dt < D / 32; ++dt) vf[s][dt] = *(const bf16x8*)(VTp + (size_t)(32 * dt + r) * ldv + key0 + 16 * s + 8 * h);
}
template <int D>
__device__ __forceinline__ f32x16 qk_frag(const bf16x8 (&kf)[D / 16], const bf16x8 (&qf)[D / 16]) {
    f32x16 s;
#pragma unroll
    for (int i = 0; i < 16; ++i) s[i] = 0.f;
#pragma unroll
    for (int k = 0; k < D / 16; ++k) s = mfma32(kf[k], qf[k], s);
    return s;
}
template <int D>
__device__ __forceinline__ void softmax_pv_frag(const f32x16& s, float& m, float& l, f32x16 (&o)[D / 32], const bf16x8 (&vf)[2][D / 32]) {
    float mt = s[0];
#pragma unroll
    for (int i = 1; i < 16; ++i) mt = fmaxf(mt, s[i]);
    mt = fmaxf(mt, __shfl_xor(mt, 32));
    const float mn = fmaxf(m, mt);
    const float mu = (mn == -INFINITY) ? 0.f : mn;
    const float alpha = __builtin_amdgcn_exp2f(m - mu);
    float p[16]; float ps = 0.f;
#pragma unroll
    for (int i = 0; i < 16; ++i) { p[i] = __builtin_amdgcn_exp2f(s[i] - mu); ps += p[i]; }
    l = l * alpha + ps;
#pragma unroll
    for (int dt = 0; dt < D / 32; ++dt)
#pragma unroll
        for (int i = 0; i < 16; ++i) o[dt][i] *= alpha;
#pragma unroll
    for (int sx = 0; sx < 2; ++sx) { const bf16x8 pb = pack8f(p + 8 * sx);
#pragma unroll
        for (int dt = 0; dt < D / 32; ++dt) o[dt] = mfma32(vf[sx][dt], pb, o[dt]); }
    m = mn;
}
template <int D>
__device__ __forceinline__ void softmax_pv(const f32x16& s, float& m, float& l, f32x16 (&o)[D / 32], const bf16_t* VTp, int ldv, int key0, int r, int h) {
    float mt = s[0];
#pragma unroll
    for (int i = 1; i < 16; ++i) mt = fmaxf(mt, s[i]);
    mt = fmaxf(mt, __shfl_xor(mt, 32));
    const float mn = fmaxf(m, mt);
    const float mu = (mn == -INFINITY) ? 0.f : mn;
    const float alpha = __builtin_amdgcn_exp2f(m - mu);
    float p[16]; float ps = 0.f;
#pragma unroll
    for (int i = 0; i < 16; ++i) { p[i] = __builtin_amdgcn_exp2f(s[i] - mu); ps += p[i]; }
    l = l * alpha + ps;
#pragma unroll
    for (int dt = 0; dt < D / 32; ++dt)
#pragma unroll
        for (int i = 0; i < 16; ++i) o[dt][i] *= alpha;
    pv_tile<D>(p, o, VTp, ldv, key0, r, h);
    m = mn;
}

__device__ __forceinline__ void nsa_item(const bf16_t* Z, const float* Zs, const bf16_t* CK, const bf16_t* CVT, const bf16_t* VTS, const bf16_t* VTW, bf16_t* O,
                                         LAS float* wl, int b, int g, int t0, int lane) {
    asm volatile("" : "+v"(lane));
    const int r = lane & 31, h = lane >> 5, tq = t0 + (r & 15), jh = r >> 4;
    const size_t row = (size_t)b * SEQ + tq;
    const float sc = 0.125f * 1.4426950408889634f;
    bf16x8 qf[4];
    { const bf16_t* qp = Z + row * NZ + ZC_NQ + (g * 2 + jh) * 64 + 8 * h;
#pragma unroll
      for (int k = 0; k < 4; ++k) qf[k] = *(const bf16x8*)(qp + 16 * k); }
    const float* gp = Zs + row * NZS + ZS_NG + (g * 2 + jh) * 3;
    const float g0 = sigmoidf_(gp[0]), g1 = sigmoidf_(gp[1]), g2 = sigmoidf_(gp[2]);
    f32x16 oc[2];
    unsigned selmask;
    {
        const bf16_t* Kp = CK + ((size_t)b * 2 + g) * 128 * 64; const bf16_t* VTp = CVT + ((size_t)b * 2 + g) * 64 * 128;
        const int nmax = tq >= 31 ? ((tq - 31) >> 4) : -1;
        f32x16 s[4]; float mx = -INFINITY;
#pragma unroll
        for (int kt = 0; kt < 4; ++kt) { s[kt] = qk_tile<64>(Kp, 64, 32 * kt, qf, r, h);
#pragma unroll
            for (int i = 0; i < 16; ++i) { const int key = 32 * kt + 16 * (i >> 3) + 8 * h + (i & 7); s[kt][i] = key <= nmax ? s[kt][i] * sc : -INFINITY; mx = fmaxf(mx, s[kt][i]); } }
        mx = fmaxf(mx, __shfl_xor(mx, 32));
        const float mu = (mx == -INFINITY) ? 0.f : mx;
        float ps = 0.f;
#pragma unroll
        for (int kt = 0; kt < 4; ++kt)
#pragma unroll
            for (int i = 0; i < 16; ++i) { s[kt][i] = __builtin_amdgcn_exp2f(s[kt][i] - mu); ps += s[kt][i]; }
        ps += __shfl_xor(ps, 32);
        const float inv = ps > 0.f ? 1.0f / ps : 0.f;
        f32x16 o[2];
#pragma unroll
        for (int dt = 0; dt < 2; ++dt)
#pragma unroll
            for (int i = 0; i < 16; ++i) o[dt][i] = 0.f;
#pragma unroll
        for (int kt = 0; kt < 4; ++kt) {
            float p[16];
#pragma unroll
            for (int i = 0; i < 16; ++i) p[i] = s[kt][i] * inv;
            pv_tile<64>(p, o, VTp, 128, 32 * kt, r, h);
#pragma unroll
            for (int q4 = 0; q4 < 4; ++q4) {
                float F = (p[4 * q4] + p[4 * q4 + 1]) + (p[4 * q4 + 2] + p[4 * q4 + 3]), L = p[4 * q4 + 3];
                F += __shfl_xor(F, 16); L += __shfl_xor(L, 16);
                const int mp = 8 * kt + 4 * (q4 >> 1) + 2 * h + (q4 & 1);
                if (r < 16) { wl[r * 32 + mp] = F; wl[512 + r * 32 + mp] = L; }
            }
        }
#pragma unroll
        for (int dt = 0; dt < 2; ++dt)
#pragma unroll
            for (int i = 0; i < 16; ++i) oc[dt][i] = g0 * o[dt][i];
        LDS_FENCE();
        const int tau = lane & 15, q = lane >> 4, tt = t0 + tau, cur = tt >> 6;
        float mine[8];
#pragma unroll
        for (int mm = 0; mm < 8; ++mm) { const int m = 8 * q + mm;
            const float imp = wl[tau * 32 + m] + (m > 0 ? wl[512 + tau * 32 + m - 1] : 0.f);
            const float val = (m == 0 || m == cur || m == cur - 1) ? INFINITY : (m > cur ? -INFINITY : imp);
            mine[mm] = val; wl[1024 + tau * 32 + m] = val; }
        LDS_FENCE();
        float v[32];
#pragma unroll
        for (int c4 = 0; c4 < 8; ++c4) { const f32x4 x = *(const LAS f32x4*)(wl + 1024 + tau * 32 + 4 * c4); v[4 * c4] = x.x; v[4 * c4 + 1] = x.y; v[4 * c4 + 2] = x.z; v[4 * c4 + 3] = x.w; }
        unsigned bits = 0u;
#pragma unroll
        for (int mm = 0; mm < 8; ++mm) { const int m = 8 * q + mm; int cnt = 0;
#pragma unroll
            for (int mp = 0; mp < 32; ++mp) cnt += (v[mp] > mine[mm] || (v[mp] == mine[mm] && mp < m)) ? 1 : 0;
            if (cnt < 16) bits |= 1u << m; }
        bits |= __shfl_xor(bits, 16); bits |= __shfl_xor(bits, 32);
        selmask = bits & ((2u << cur) - 1u);
        LDS_FENCE();
    }
    const int ktmax = (t0 + 15) >> 5;
    {
        const bf16_t* Kp = Z + (size_t)b * SEQ * NZ + ZC_NKS + g * 64; const bf16_t* VTp = VTS + ((size_t)b * 2 + g) * 64 * SEQ;
        float m = -INFINITY, l = 0.f; f32x16 o[2];
#pragma unroll
        for (int dt = 0; dt < 2; ++dt)
#pragma unroll
            for (int i = 0; i < 16; ++i) o[dt][i] = 0.f;
        unsigned um = selmask;
        um |= __shfl_xor(um, 1); um |= __shfl_xor(um, 2); um |= __shfl_xor(um, 4); um |= __shfl_xor(um, 8);
        um = (unsigned)__builtin_amdgcn_readfirstlane((int)um);
        bf16x8 kf[4], kfn[4], vf[2][2];
        int kt = 0;
        load_k<64>(Kp, NZ, 0, r, h, kf);
        while (kt >= 0) {
            int ktn = kt + 1;
            while (ktn <= ktmax && !((um >> (ktn >> 1)) & 1u)) ktn = (ktn | 1) + 1;
            if (ktn > ktmax) ktn = -1;
            load_v<64>(VTp, SEQ, 32 * kt, r, h, vf);
            if (ktn >= 0) load_k<64>(Kp, NZ, 32 * ktn, r, h, kfn);
            const bool sel = (selmask >> (kt >> 1)) & 1u;
            f32x16 s = qk_frag<64>(kf, qf);
            if (32 * kt + 31 <= t0) {
                const float scl = sel ? sc : 0.f, bia = sel ? 0.f : -INFINITY;
#pragma unroll
                for (int i = 0; i < 16; ++i) s[i] = s[i] * scl + bia;
            } else {
#pragma unroll
                for (int i = 0; i < 16; ++i) { const int key = 32 * kt + 16 * (i >> 3) + 8 * h + (i & 7); s[i] = (sel && key <= tq) ? s[i] * sc : -INFINITY; } }
            softmax_pv_frag<64>(s, m, l, o, vf);
            if (ktn >= 0) {
#pragma unroll
                for (int k = 0; k < 4; ++k) kf[k] = kfn[k]; }
            kt = ktn;
        }
        l += __shfl_xor(l, 32);
        const float f = l > 0.f ? g1 / l : 0.f;
#pragma unroll
        for (int dt = 0; dt < 2; ++dt)
#pragma unroll
            for (int i = 0; i < 16; ++i) oc[dt][i] += f * o[dt][i];
    }
    {
        const bf16_t* Kp = Z + (size_t)b * SEQ * NZ + ZC_NKW + g * 64; const bf16_t* VTp = VTW + ((size_t)b * 2 + g) * 64 * SEQ;
        float m = -INFINITY, l = 0.f; f32x16 o[2];
#pragma unroll
        for (int dt = 0; dt < 2; ++dt)
#pragma unroll
            for (int i = 0; i < 16; ++i) o[dt][i] = 0.f;
        const int ktlo = (t0 - 511) > 0 ? ((t0 - 511) >> 5) : 0;
        bf16x8 kf[4], kfn[4], vf[2][2];
        load_k<64>(Kp, NZ, 32 * ktlo, r, h, kf);
        for (int kt = ktlo; kt <= ktmax; ++kt) {
            load_v<64>(VTp, SEQ, 32 * kt, r, h, vf);
            if (kt < ktmax) load_k<64>(Kp, NZ, 32 * (kt + 1), r, h, kfn);
            f32x16 s = qk_frag<64>(kf, qf);
            if (32 * kt + 31 <= t0 && 32 * kt > t0 + 15 - 512) {
#pragma unroll
                for (int i = 0; i < 16; ++i) s[i] *= sc;
            } else {
#pragma unroll
                for (int i = 0; i < 16; ++i) { const int key = 32 * kt + 16 * (i >> 3) + 8 * h + (i & 7); s[i] = (key <= tq && key > tq - 512) ? s[i] * sc : -INFINITY; } }
            softmax_pv_frag<64>(s, m, l, o, vf);
            if (kt < ktmax) {
#pragma unroll
                for (int k = 0; k < 4; ++k) kf[k] = kfn[k]; }
        }
        l += __shfl_xor(l, 32);
        const float f = l > 0.f ? g2 / l : 0.f;
#pragma unroll
        for (int dt = 0; dt < 2; ++dt)
#pragma unroll
            for (int i = 0; i < 16; ++i) oc[dt][i] += f * o[dt][i];
    }
    bf16_t* op = O + row * DM + 768 + (g * 2 + jh) * 64 + 4 * h;
#pragma unroll
    for (int dt = 0; dt < 2; ++dt)
#pragma unroll
        for (int q4 = 0; q4 < 4; ++q4) { u32x2 w; w.x = pk2(oc[dt][4 * q4], oc[dt][4 * q4 + 1]); w.y = pk2(oc[dt][4 * q4 + 2], oc[dt][4 * q4 + 3]); *(u32x2*)(op + 32 * dt + 8 * q4) = w; }
}

__device__ __forceinline__ void xattn_item(bf16_t* XQ, const bf16_t* KV, const bf16_t* VTm, int rt, int hh, int lane) {
    asm volatile("" : "+v"(lane));
    const int r = lane & 31, h = lane >> 5;
    const size_t row = (size_t)rt * 32 + r; const int b = (int)(row >> 11);
    bf16x8 qf[8];
    { const bf16_t* qp = XQ + row * 512 + hh * 128 + 8 * h;
#pragma unroll
      for (int k = 0; k < 8; ++k) qf[k] = *(const bf16x8*)(qp + 16 * k); }
    const bf16_t* Kp = KV + (size_t)b * MEML * DM + hh * 128; const bf16_t* VTp = VTm + ((size_t)b * 4 + hh) * 128 * MEML;
    const float sc = 0.08838834764831845f * 1.4426950408889634f;
    float m = -INFINITY, l = 0.f; f32x16 o[4];
#pragma unroll
    for (int dt = 0; dt < 4; ++dt)
#pragma unroll
        for (int i = 0; i < 16; ++i) o[dt][i] = 0.f;
    bf16x8 kf[8], kfn[8], vf[2][4];
    load_k<128>(Kp, DM, 0, r, h, kf);
    for (int kt = 0; kt < 8; ++kt) {
        load_v<128>(VTp, MEML, 32 * kt, r, h, vf);
        if (kt < 7) load_k<128>(Kp, DM, 32 * (kt + 1), r, h, kfn);
        f32x16 s = qk_frag<128>(kf, qf);
#pragma unroll
        for (int i = 0; i < 16; ++i) s[i] *= sc;
        softmax_pv_frag<128>(s, m, l, o, vf);
        if (kt < 7) {
#pragma unroll
            for (int k = 0; k < 8; ++k) kf[k] = kfn[k]; }
    }
    l += __shfl_xor(l, 32);
    const float f = 1.0f / l;
    bf16_t* op = XQ + row * 512 + hh * 128 + 4 * h;
#pragma unroll
    for (int dt = 0; dt < 4; ++dt)
#pragma unroll
        for (int q4 = 0; q4 < 4; ++q4) { u32x2 w; w.x = pk2(o[dt][4 * q4] * f, o[dt][4 * q4 + 1] * f); w.y = pk2(o[dt][4 * q4 + 2] * f, o[dt][4 * q4 + 3] * f); *(u32x2*)(op + 32 * dt + 8 * q4) = w; }
}

__device__ __forceinline__ void act_item(const bf16_t* UV, bf16_t* ACT, const float* cw, const float* cb, int rb, int cg) {
    const int c0 = cg * 8, ucol = (c0 >> 7) * 256 + (c0 & 127);
    float w0[8], w1[8], w2[8], bb[8];
#pragma unroll
    for (int j = 0; j < 8; ++j) { w0[j] = cw[c0 + j]; w1[j] = cw[DFF + c0 + j]; w2[j] = cw[2 * DFF + c0 + j]; bb[j] = cb[c0 + j]; }
    float u1[8], u2[8];
    const int r0 = rb * 32;
    const bool seq_start = (r0 & (SEQ - 1)) == 0;
    {
        u32x4 a = (u32x4){0u, 0u, 0u, 0u}, c = (u32x4){0u, 0u, 0u, 0u};
        if (!seq_start) { a = *(const u32x4*)(UV + (size_t)(r0 - 1) * NUP + ucol); c = *(const u32x4*)(UV + (size_t)(r0 - 2) * NUP + ucol); }
        unpack8(a, u1); unpack8(c, u2);
    }
    for (int rq = 0; rq < 8; ++rq) {
        u32x4 ua[4], va[4];
#pragma unroll
        for (int i = 0; i < 4; ++i) { const size_t row = (size_t)r0 + rq * 4 + i; ua[i] = *(const u32x4*)(UV + row * NUP + ucol); va[i] = *(const u32x4*)(UV + row * NUP + ucol + 128); }
#pragma unroll
        for (int i = 0; i < 4; ++i) {
            const size_t row = (size_t)r0 + rq * 4 + i;
            float u0[8], vv[8], o[8];
            unpack8(ua[i], u0); unpack8(va[i], vv);
#pragma unroll
            for (int j = 0; j < 8; ++j) { const float x = w0[j] * u2[j] + w1[j] * u1[j] + w2[j] * u0[j] + bb[j]; o[j] = gelu_tanh(x) * vv[j]; u2[j] = u1[j]; u1[j] = u0[j]; }
            *(u32x4*)(ACT + row * DFF + c0) = cvt8(o[0], o[1], o[2], o[3], o[4], o[5], o[6], o[7]);
        }
    }
}

__device__ __forceinline__ void ffn_fix_item(const float* stash, bf16_t* ACT, const float* cw, const float* cb, int it) {
    const int cg = it & 15, j = (it >> 4) % 22, pm = it / (16 * 22), c0 = 128 * j + 8 * cg;
    const float* st = stash + ((size_t)(pm * 22 + j) * 6) * 128 + 8 * cg;
    float u0[8], u1[8], v0[8], v1[8], pa[8], pb[8];
#pragma unroll
    for (int e = 0; e < 8; ++e) { u0[e] = st[e]; u1[e] = st[128 + e]; v0[e] = st[4 * 128 + e]; v1[e] = st[5 * 128 + e]; pa[e] = 0.f; pb[e] = 0.f; }
    if (pm & 7) { const float* sp = stash + ((size_t)((pm - 1) * 22 + j) * 6) * 128 + 8 * cg;
#pragma unroll
        for (int e = 0; e < 8; ++e) { pa[e] = sp[2 * 128 + e]; pb[e] = sp[3 * 128 + e]; } }
    float o0[8], o1[8];
#pragma unroll
    for (int e = 0; e < 8; ++e) { const float w0 = cw[c0 + e], w1 = cw[DFF + c0 + e], w2 = cw[2 * DFF + c0 + e], b = cb[c0 + e];
        o0[e] = gelu_tanh(w0 * pa[e] + w1 * pb[e] + w2 * u0[e] + b) * v0[e];
        o1[e] = gelu_tanh(w0 * pb[e] + w1 * u0[e] + w2 * u1[e] + b) * v1[e]; }
    *(u32x4*)(ACT + (size_t)(pm * 256) * DFF + c0) = cvt8(o0[0], o0[1], o0[2], o0[3], o0[4], o0[5], o0[6], o0[7]);
    *(u32x4*)(ACT + (size_t)(pm * 256 + 1) * DFF + c0) = cvt8(o1[0], o1[1], o1[2], o1[3], o1[4], o1[5], o1[6], o1[7]);
}

constexpr int PH_PRO = 0, PH_MEMKV = 1, PH_VTMEM = 2, PH_L0 = 3, NPL = 18, NPH = PH_L0 + NLAYER * NPL;

__global__ void __launch_bounds__(NWAVES * 64, 2) fwd_kernel(Args args) {
    extern __shared__ __attribute__((aligned(16))) unsigned char lds_raw[];
    LAS unsigned char* lds = (LAS unsigned char*)lds_raw;
    const int tid0 = threadIdx.x, wave0 = __builtin_amdgcn_readfirstlane(tid0 >> 6);
    constexpr int G = 256;
    const int vcu0 = (G % 8 == 0) ? ((int)blockIdx.x % 8) * (G / 8) + (int)blockIdx.x / 8 : (int)blockIdx.x;
    constexpr int NGW = G * NWAVES;
#define PH_VARS int wave = wave0, vcu = vcu0; asm volatile("" : "+s"(wave), "+s"(vcu)); \
    int tid = wave * 64 + (int)__builtin_amdgcn_mbcnt_hi(~0u, __builtin_amdgcn_mbcnt_lo(~0u, 0u)); asm volatile("" : "+v"(tid));     \
    unsigned char* ws = ws0; float* X = X0; asm volatile("" : "+s"(ws), "+s"(X)); (void)X; \
    const int lane = tid & 63, gw = vcu * NWAVES + wave; LAS unsigned char* wlds = lds + wave * 16384; (void)lane; (void)gw; (void)wlds;
#define PH_VARS_L PH_VARS int l = l0; asm volatile("" : "+s"(l)); unsigned char* wbase = ws + WS_W + (size_t)l * W_STRIDE; const float* Xin = (l == 0) ? args.in[0] : X; (void)wbase; (void)Xin;
    unsigned char* ws0 = args.ws;
    float* X0 = args.out;
    for (int u = tid0; u < (LDS_BYTES - RING_BYTES) / 4; u += NWAVES * 64) ((LAS unsigned*)(lds + RING_BYTES))[u] = 0u;
    __syncthreads();
    XcdBarrier bar; bar.bar = (unsigned*)(ws0 + WS_CTL) + CW_BAR; bar.x = 0; bar.st = nullptr;
    if (args.use_bar) bar = xcd_barrier_post((unsigned*)(ws0 + WS_CTL) + CW_BAR, (volatile LAS unsigned*)(lds + MISC_OFF) + 8);
    const int lo = args.ph_lo, hi = args.ph_hi;
#define IN(k) (lo <= (k) && (k) < hi)
#define REPF(bit) for (int rp_ = 0; rp_ <= ((args.rep_mix >> (bit)) & 1); ++rp_)
#define SEAM(k) do { if (IN(k) && IN((k) + 1)) xcd_barrier(bar); } while (0)

#define Hb ((bf16_t*)(ws + WS_H))
#define Zb ((bf16_t*)(ws + WS_Z))
#define Ob ((bf16_t*)(ws + WS_O))
#define Yb ((bf16_t*)(ws + WS_Y))
#define Zs ((float*)(ws + WS_ZS))
#define XQ ((bf16_t*)(ws + WS_XQ))
#define CK ((bf16_t*)(ws + WS_CK))
#define CVT ((bf16_t*)(ws + WS_CVT))
#define PH ((float*)(ws + WS_PH))
#define VTS ((bf16_t*)(ws + WS_VTS))
#define VTW ((bf16_t*)(ws + WS_VTW))
#define MemKV ((bf16_t*)(ws + WS_MEMKV))
#define VTmem ((bf16_t*)(ws + WS_VTMEM))
#define MemN ((bf16_t*)(ws + WS_MEMN))
#define C0P ((float*)(ws + WS_C0P))
#define UV ((bf16_t*)(ws + WS_UV))
#define ACT ((bf16_t*)(ws + WS_ACT))

    if (IN(PH_PRO)) { PH_VARS
        LAS float* scr = (LAS float*)wlds;
        int base = 0;
        for (int l = 0; l < NLAYER; ++l)
            for (int j = 0; j < 19; ++j) {
                const TrJob q = tr_job(args, ws, l, j);
                int it = (gw - base) % NGW; if (it < 0) it += NGW;
                for (; it < q.nitems; it += NGW) tr_item(q.W, q.ldw, q.WT, q.ldd, q.dk0, q.map, q.r_off, q.nkb, it, scr, lane);
                base = (base + q.nitems) % NGW;
            }
        for (int it = gw; it < NLAYER * 2 * 8; it += NGW) {
            const int l = it >> 4, kv = (it >> 3) & 1, s = it & 7;
            const float* pe = args.in[13] + ((size_t)l * 2 + kv) * 32 * 64 + (size_t)s * 4 * 64;
            const float* w1 = args.in[14] + ((size_t)l * 2 + kv) * 2048 * 64 + (size_t)s * 4 * 64 * 64;
            float a = 0.f;
            for (int i = 0; i < 256; ++i) a += pe[i] * w1[(size_t)i * 64 + lane];
            C0P[(size_t)it * 64 + lane] = a;
        }
        for (int m = gw; m < NLAYER * NB * MEML; m += NGW) { const int l = m / (NB * MEML), rr = m % (NB * MEML);
            rms_row_bf16(args.in[1] + (size_t)rr * DM, args.in[21] + (size_t)l * DM, MemN + (size_t)m * DM, lane); }
        for (int m = gw; m < T; m += NGW) xg_row_bf16(args.in[0] + (size_t)m * DM, args.in[2], Hb + (size_t)m * DM, (float*)(ws + WS_SS) + m, lane);
    }
    SEAM(PH_PRO);
    if (IN(PH_MEMKV)) { PH_VARS
        const int l = vcu >> 7, rr = vcu & 127, pm = rr >> 2, pn = rr & 3;
        pg8::SchedOne S{(const char*)(MemN + ((size_t)l * 8192 + pm * 256) * DM), (const char*)(ws + WS_W + (size_t)l * W_STRIDE + WO_KV) + (size_t)pn * 256 * DM * 2, 16, pm * 256, pn * 256};
        pg8::EpiBf16S E{MemKV + (size_t)l * 8192 * DM, DM, nullptr, 0};
        for (int rep = 0; rep <= ((args.rep_gemm >> 4) & 1); ++rep) { int tid_r = tid; asm volatile("" : "+v"(tid_r)); pg8::gemm_phase(lds, tid_r, DM, S, E); }
    }
    SEAM(PH_MEMKV);
    if (IN(PH_VTMEM)) { PH_VARS
        for (int it = gw; it < NLAYER * NB * 4 * 4 * 2; it += NGW) {
            const int db = it & 1, kb = (it >> 1) & 3, hh = (it >> 3) & 3, b = (it >> 5) & 31, l = it >> 10;
            tr64(MemKV + ((size_t)l * 8192 + b * MEML + kb * 64) * DM + 512 + hh * 128 + db * 64, DM,
                 VTmem + ((((size_t)l * NB + b) * 4 + hh) * 128 + db * 64) * MEML + kb * 64, MEML, (LAS bf16_t*)wlds, lane);
        }
    }
    SEAM(PH_VTMEM);

    for (int l0 = 0; l0 < NLAYER; ++l0) {
        const int pb = PH_L0 + l0 * NPL;
        if (IN(pb + 0)) { PH_VARS_L
            pg8::SchedG S{(const char*)Hb, (const char*)(wbase + WO_IN), DM, 16, 13, 32, 8, 0, 0, vcu >> 5, vcu & 31, 1};
            pg8::EpiZ E{Zb, Zs, (const float*)(ws + WS_SS)};
            for (int rep = 0; rep <= ((args.rep_gemm >> 0) & 1); ++rep) { int tid_r = tid; asm volatile("" : "+v"(tid_r)); pg8::gemm_phase(lds, tid_r, DM, S, E); }
        }
        SEAM(pb + 0);
        for (int rep = 0; rep <= (args.rep_mix & 1); ++rep) {
        if (IN(pb + 1)) { PH_VARS_L
            for (int i = vcu * 512 + tid; i < 2 * T; i += G * 512) ((float*)(ws + WS_SS))[T + i] = 0.f;
            REPF(9) for (int it = gw; it < 2 * NB * 2 * 8; it += NGW) { const int mg = it & 7, g = (it >> 3) & 1, b = (it >> 4) & 31, kv = it >> 9;
                cmp1_item(Zb, (const bf16_t*)(wbase + WO_C1), PH, kv, b, g, mg, lane); }
            REPF(9) for (int it = gw; it < 2 * NB * 2 * 32; it += NGW) { const int tb = it & 31, g = (it >> 5) & 1, b = (it >> 6) & 31, sel = it >> 11;
                tr64(Zb + (size_t)(b * SEQ + tb * 64) * NZ + (sel ? ZC_NVW : ZC_NVS) + g * 64, NZ, (sel ? VTW : VTS) + ((size_t)b * 2 + g) * 64 * SEQ + tb * 64, SEQ, (LAS bf16_t*)wlds, lane); }
            REPF(5) for (int it = gw; it < NB * 4 * 32; it += NGW) { const int n = it & 31, h = (it >> 5) & 3, b = it >> 7;
                gdn_prep(Zb, Zs, args.in[9] + (size_t)l * 4 * 768, args.in[10] + (size_t)l * 4, args.in[11] + (size_t)l * 4,
                         (bf16_t*)(ws + WS_GDN_KT), (bf16_t*)(ws + WS_GDN_QN), (bf16_t*)(ws + WS_GDN_KN), (bf16_t*)(ws + WS_GDN_XVT), (float*)(ws + WS_GDN_AB), b, h, n, lane); }
            REPF(6) for (int it = gw; it < NB * 4 * 32; it += NGW) { const int n = it & 31, h = (it >> 5) & 3, b = it >> 7;
                gla_prep(Zb, Zs, args.in[6] + (size_t)l * 16 * 128, args.in[7] + (size_t)l * 128, (bf16_t*)(ws + WS_GLA_KUT), (bf16_t*)(ws + WS_GLA_QE), (bf16_t*)(ws + WS_GLA_KE), (float*)(ws + WS_GLA_DEC), b, h, n, lane); }
        }
        SEAM(pb + 1);
        if (IN(pb + 2)) { PH_VARS_L
            for (int it = gw; it < 2 * NB * 2 * 128; it += NGW) { const int n = it & 127, g = (it >> 7) & 1, b = (it >> 8) & 31, kv = it >> 13;
                cmp2_item(PH, C0P + (size_t)l * 2 * 8 * 64, args.in[15] + (size_t)l * 2 * 64 * 64, CK, CVT, (LAS float*)(lds + RING_BYTES + 1024) + wave * 64, kv, b, g, n, lane); }
        }
        SEAM(pb + 2);
        if (IN(pb + 3)) { PH_VARS_L
            if (wave == 0 && vcu < 128)
              REPF(3)
                gdn_seq(Zb, (const bf16_t*)(ws + WS_GDN_KT), (const bf16_t*)(ws + WS_GDN_QN), (const bf16_t*)(ws + WS_GDN_KN), (const bf16_t*)(ws + WS_GDN_XVT), (const float*)(ws + WS_GDN_AB),
                        args.in[12] + (size_t)l * 64, Ob, lds, lds + RING_BYTES + 4096, lds + RING_BYTES + 4096 + 16384, vcu >> 2, vcu & 3, lane);
            if (wave == 0 && vcu >= 128)
              REPF(4)
                gla_seq(Zb, (const bf16_t*)(ws + WS_GLA_KUT), (const bf16_t*)(ws + WS_GLA_QE), (const bf16_t*)(ws + WS_GLA_KE), (const float*)(ws + WS_GLA_DEC), args.in[8] + (size_t)l * 64, Ob,
                        lds, (vcu - 128) >> 2, (vcu - 128) & 3, lane);
            unsigned* qhead = (unsigned*)(ws + WS_CTL) + CW_QUEUE + 64 * l;
            for (;;) {
                unsigned it = 0u;
                if (lane == 0) it = __hip_atomic_fetch_add(qhead, 1u, __ATOMIC_RELAXED, __HIP_MEMORY_SCOPE_AGENT);
                it = (unsigned)__builtin_amdgcn_readfirstlane((int)it);
                if (it >= (unsigned)(NB * 2 * 128 + NB * 4 * 32)) break;
                if (it < (unsigned)(NB * 2 * 128)) { const int bg = it & 63, tb = 127 - (int)(it >> 6);
                  nsa_item(Zb, Zs, CK, CVT, VTS, VTW, Ob, (LAS float*)wlds, bg >> 1, bg & 1, tb * 16, lane); }
                else { const int i2 = (int)it - NB * 2 * 128, tb = i2 & 31, g = (i2 >> 5) & 3, b = i2 >> 7;
                  pool_item(Zb, Ob, args.in[4] + (size_t)l * 4 * 64 * 64, args.in[5] + (size_t)l * 256, (LAS float*)wlds, b, g, tb * 64, lane); }
            }
        }
        SEAM(pb + 3);
        }
        if (IN(pb + 4)) { PH_VARS_L
            pg8::SchedY2 S{(const char*)Hb, (const char*)Ob, (const char*)(wbase + WO_B), (const char*)(wbase + WO_G), vcu >> 5, vcu & 31};
            unsigned char* scr = ws + WS_SCR + (size_t)vcu * (512 * 1024);
            pg8::EpiY E{Yb, args.in[18] + (size_t)l * 4 * DM, (const float*)(ws + WS_SS), __builtin_amdgcn_make_buffer_rsrc((void*)scr, 0, 512 * 1024, 0x00020000)};
            for (int rep = 0; rep <= ((args.rep_gemm >> 1) & 1); ++rep) { int tid_r = tid; asm volatile("" : "+v"(tid_r)); pg8::gemm_phase(lds, tid_r, DM, S, E); }
        }
        SEAM(pb + 4);
        if (IN(pb + 5)) { PH_VARS_L
            pg8::SchedG S{(const char*)Yb, (const char*)(wbase + WO_OUT), DM, 16, 4, 32, 8, 0, 0, vcu >> 5, vcu & 31, 0};
            pg8::EpiRes E{Xin, X, Hb, args.in[20] + (size_t)l * DM, (float*)(ws + WS_SS) + T};
            pg8::gemm_phase(lds, tid, DM, S, E);
        }
        SEAM(pb + 5);
        if (IN(pb + 7)) { PH_VARS_L
            pg8::SchedG S{(const char*)Hb, (const char*)(wbase + WO_XQ), DM, 16, 2, 32, 16, 0, 0, vcu >> 5, vcu & 31, 0};
            pg8::EpiBf16S E{XQ, 512, (const float*)(ws + WS_SS) + T, 0};
            for (int rep = 0; rep <= ((args.rep_gemm >> 2) & 1); ++rep) { int tid_r = tid; asm volatile("" : "+v"(tid_r)); pg8::gemm_phase(lds, tid_r, DM, S, E); }
        }
        SEAM(pb + 7);
        if (IN(pb + 8)) { PH_VARS_L
            for (int i = vcu * 512 + tid; i < T; i += G * 512) ((float*)(ws + WS_SS))[i] = 0.f;
            for (int it = gw; it < (T / 32) * 4; it += NGW) xattn_item(XQ, MemKV + (size_t)l * 8192 * DM, VTmem + (size_t)l * NB * 4 * 128 * MEML, it >> 2, it & 3, lane);
        }
        SEAM(pb + 8);
        if (IN(pb + 9)) { PH_VARS_L
            pg8::SchedG S{(const char*)XQ, (const char*)(wbase + WO_XO), 512, 8, 4, 32, 8, 0, 0, vcu >> 5, vcu & 31, 0};
            pg8::EpiRes E{X, X, Hb, args.in[25] + (size_t)l * DM, (float*)(ws + WS_SS) + 2 * T};
            pg8::gemm_phase(lds, tid, 512, S, E);
        }
        SEAM(pb + 9);
        if (IN(pb + 11)) { PH_VARS_L
            unsigned keep0 = 0u, keep1 = 0u;
            if (tid == 0) { keep0 = ((volatile LAS unsigned*)(lds + MISC_OFF))[8]; keep1 = ((volatile LAS unsigned*)(lds + MISC_OFF))[9]; }
            __syncthreads();
            pg8::SchedG S{(const char*)Hb, (const char*)(wbase + WO_UP), DM, 16, 22, 32, 8, 0, 0, vcu >> 5, vcu & 31, 0};
            pg8::EpiUp E{ACT, (const float*)(ws + WS_SS) + 2 * T, args.in[27] + (size_t)l * 3 * DFF, args.in[28] + (size_t)l * DFF, (float*)(ws + WS_STASH), lds + RING_BYTES};
            for (int rep = 0; rep <= ((args.rep_gemm >> 3) & 1); ++rep) { int tid_r = tid; asm volatile("" : "+v"(tid_r)); pg8::gemm_phase(lds, tid_r, DM, S, E); }
            __syncthreads();
            if (tid == 0) { ((volatile LAS unsigned*)(lds + MISC_OFF))[8] = keep0; ((volatile LAS unsigned*)(lds + MISC_OFF))[9] = keep1; }
            __syncthreads();
        }
        SEAM(pb + 11);
        if (IN(pb + 12)) { PH_VARS_L
            for (int it = vcu * 512 + tid; it < 256 * 22 * 16; it += G * 512) ffn_fix_item((const float*)(ws + WS_STASH), ACT, args.in[27] + (size_t)l * 3 * DFF, args.in[28] + (size_t)l * DFF, it);
        }
        SEAM(pb + 12);
        if (IN(pb + 13)) { PH_VARS_L
            pg8::SchedG S{(const char*)ACT, (const char*)(wbase + WO_DN), DFF, 44, 4, 32, 8, 0, 0, vcu >> 5, vcu & 31, 0};
            pg8::EpiRes E{X, X, Hb, (l + 1 < NLAYER) ? args.in[2] + (size_t)(l + 1) * DM : args.in[30], (float*)(ws + WS_SS)};
            pg8::gemm_phase(lds, tid, DFF, S, E);
        }
        SEAM(pb + 13);
        if (IN(pb + 17)) { PH_VARS_L
            if (l + 1 == NLAYER) { for (int m = gw; m < T; m += NGW) rms_row_f32(X + (size_t)m * DM, args.in[30], lane); }
        }
        SEAM(pb + 17);
    }
#undef IN
#undef SEAM
}
#undef Hb
#undef Zb
#undef Ob
#undef Yb
#undef Zs
#undef XQ
#undef CK
#undef CVT
#undef PH
#undef VTS
#undef VTW
#undef MemKV
#undef VTmem
#undef MemN
#undef C0P
#undef UV
#undef ACT
#undef PH_VARS
#undef PH_VARS_L

extern "C" void kernel_launch(void* const* d_in, const int* in_sizes, int n_in, void* d_out, int out_size, void* d_ws, size_t ws_size, hipStream_t stream) {
    static int grid = 0;
    if (grid == 0) {
        if (n_in != 31 || out_size != T * DM || ws_size < WS_END) { fprintf(stderr, "kernel_launch: unexpected shapes (n_in %d, out %d, ws %zu); nothing launched\n", n_in, out_size, ws_size); grid = -1; return; }
        int dev = 0, cus = 0;
        if (hipGetDevice(&dev) != hipSuccess || hipDeviceGetAttribute(&cus, hipDeviceAttributeMultiprocessorCount, dev) != hipSuccess) { grid = -1; return; }
        if (hipFuncSetAttribute((const void*)fwd_kernel, hipFuncAttributeMaxDynamicSharedMemorySize, LDS_BYTES) != hipSuccess) { grid = -1; return; }
        int per_cu = 0;
        (void)hipOccupancyMaxActiveBlocksPerMultiprocessor(&per_cu, (const void*)fwd_kernel, NWAVES * 64, LDS_BYTES);
        (void)hipGetLastError();
        grid = (cus == 256 && per_cu >= 1) ? 256 : -1;
        if (grid < 0) { fprintf(stderr, "kernel_launch: needs 256 CUs with one resident workgroup each (cus %d, per_cu %d)\n", cus, per_cu); return; }
    }
    if (grid < 0) return;
    (void)hipMemsetAsync((char*)d_ws + WS_CTL, 0, CTL_ZERO_BYTES, stream);
    Args a{};
    for (int i = 0; i < 31; ++i) a.in[i] = (const float*)d_in[i];
    a.out = (float*)d_out; a.ws = (unsigned char*)d_ws; a.rep_gemm = PROBE_REP_GEMM; a.rep_mix = PROBE_REP_MIX; a.rep_mem = PROBE_REP_MEM;
#if MK_N_LAUNCHES == 1
    a.ph_lo = 0; a.ph_hi = NPH; a.use_bar = 1;
    hipLaunchKernelGGL(fwd_kernel, dim3(grid), dim3(NWAVES * 64), LDS_BYTES, stream, a);
#else
    for (int p = 0; p < NPH; ++p) { a.ph_lo = p; a.ph_hi = p + 1; a.use_bar = 0; hipLaunchKernelGGL(fwd_kernel, dim3(grid), dim3(NWAVES * 64), LDS_BYTES, stream, a); }
#endif
}
```

```cpp
#include <hip/hip_runtime.h>
#include <cstdio>
#include <cstdint>

#ifndef PROBE_REP_GEMM
#define PROBE_REP_GEMM 0
#endif
#ifndef PROBE_REP_MIX
#define PROBE_REP_MIX 0
#endif
#ifndef PROBE_REP_MEM
#define PROBE_REP_MEM 0
#endif
#ifndef MK_N_LAUNCHES
#define MK_N_LAUNCHES 1
#endif

#define GAS __attribute__((address_space(1)))
#define LAS __attribute__((address_space(3)))
typedef unsigned short bf16_t;
typedef short bf16x8 __attribute__((ext_vector_type(8)));
typedef float f32x4 __attribute__((ext_vector_type(4)));
typedef float f32x16 __attribute__((ext_vector_type(16)));
typedef unsigned u32x4 __attribute__((ext_vector_type(4)));
typedef unsigned u32x2 __attribute__((ext_vector_type(2)));

constexpr int NB = 32, SEQ = 2048, T = NB * SEQ, DM = 1024, NLAYER = 2;
constexpr int NZ = 3072, NZS = 64, NWIN = 3328;
constexpr int DFF = 2816, NUP = 2 * DFF, MEML = 256;
constexpr int TH = T / 2;
constexpr float EPS = 1e-6f;
constexpr int ZC_POOL = 0, ZC_AQ = 256, ZC_AK = 384, ZC_AV = 512, ZC_AR = 768;
constexpr int ZC_DQ = 1024, ZC_DK = 1280, ZC_DV = 1536, ZC_DG = 1792;
constexpr int ZC_NQ = 2048, ZC_NKC = 2304, ZC_NVC = 2432, ZC_NKS = 2560, ZC_NVS = 2688, ZC_NKW = 2816, ZC_NVW = 2944;
constexpr int ZS_LR = 0, ZS_DB = 16, ZS_DA = 20, ZS_NG = 24;

constexpr size_t MiB = 1u << 20;
constexpr size_t WS_CTL = 0, CTL_ZERO_BYTES = 1 * MiB;
constexpr size_t WS_W = 2 * MiB, W_STRIDE = 40 * MiB;
constexpr size_t WO_IN = 0, WO_G = 7 * MiB, WO_B = 15 * MiB, WO_OUT = 17 * MiB, WO_XQ = 19 * MiB, WO_KV = 20 * MiB, WO_XO = 22 * MiB,
                 WO_UP = 23 * MiB, WO_DN = 34 * MiB, WO_C1 = 39 * MiB + MiB / 2;
constexpr size_t WS_MEMKV = 82 * MiB;
constexpr size_t WS_VTMEM = 114 * MiB;
constexpr size_t WS_ZS = 130 * MiB;
constexpr size_t WS_CK = 146 * MiB;
constexpr size_t WS_CVT = 147 * MiB;
constexpr size_t WS_PH = 148 * MiB;
constexpr size_t WS_VTS = 156 * MiB;
constexpr size_t WS_VTW = 172 * MiB;
constexpr size_t WS_XQ = 188 * MiB;
constexpr size_t WS_C0P = 252 * MiB;
constexpr size_t WS_SS = 253 * MiB;
constexpr size_t WS_H = 256 * MiB;
constexpr size_t WS_Z = 384 * MiB;
constexpr size_t WS_O = 768 * MiB;
constexpr size_t WS_Y = 896 * MiB;
constexpr size_t WS_END = 1024 * MiB;
constexpr size_t WS_SCR = WS_Z;
constexpr size_t WS_UV = WS_Z;
constexpr size_t WS_ACT = WS_Z;
constexpr size_t WS_STASH = WS_XQ;
constexpr size_t WS_MEMN = WS_O;
constexpr size_t WS_GDN_S = WS_Y;
constexpr size_t WS_GDN_P = WS_Y + 64 * MiB;
constexpr size_t WS_GLA_S = WS_XQ;
constexpr size_t WS_GLA_D = WS_XQ + 32 * MiB;
constexpr size_t WS_GDN_KT = WS_Y, WS_GDN_QN = WS_Y + 32 * MiB, WS_GDN_KN = WS_Y + 64 * MiB, WS_GDN_XVT = WS_Y + 96 * MiB;
constexpr size_t WS_GDN_AB = WS_XQ + 48 * MiB;
constexpr size_t WS_GLA_KUT = WS_XQ, WS_GLA_QE = WS_XQ + 16 * MiB, WS_GLA_KE = WS_XQ + 32 * MiB, WS_GLA_DEC = WS_XQ + 50 * MiB;
constexpr int CW_QUEUE = 8192;
constexpr int CW_BAR = 4096;

constexpr int RING_BYTES = 131072;
constexpr int MISC_OFF = RING_BYTES + 320;
constexpr int LDS_BYTES = 163840;
constexpr int NWAVES = 8;

__device__ __forceinline__ float bf2f(unsigned v) { return __uint_as_float(v << 16); }
__device__ __forceinline__ unsigned f2bf(float f) { unsigned u = __float_as_uint(f); return (u + 0x7fffu + ((u >> 16) & 1u)) >> 16; }
__device__ __forceinline__ unsigned pk2(float lo, float hi) { return f2bf(lo) | (f2bf(hi) << 16); }
__device__ __forceinline__ u32x4 cvt8(float a0, float a1, float a2, float a3, float a4, float a5, float a6, float a7) {
    u32x4 p;
    asm("s_nop 11\n\tv_cvt_pk_bf16_f32 %0, %4, %5\n\tv_cvt_pk_bf16_f32 %1, %6, %7\n\tv_cvt_pk_bf16_f32 %2, %8, %9\n\tv_cvt_pk_bf16_f32 %3, %10, %11\n\ts_nop 1"
        : "=&v"(p[0]), "=&v"(p[1]), "=&v"(p[2]), "=&v"(p[3]) : "v"(a0), "v"(a1), "v"(a2), "v"(a3), "v"(a4), "v"(a5), "v"(a6), "v"(a7));
    return p;
}
__device__ __forceinline__ float rdlane(float v, int l) { return __int_as_float(__builtin_amdgcn_readlane(__float_as_int(v), l)); }
#define DPP_ADD_(v, ctrl, rmask) v += __int_as_float(__builtin_amdgcn_update_dpp(0, __float_as_int(v), ctrl, rmask, 0xf, false))
__device__ __forceinline__ float wave_sum(float v) {
    DPP_ADD_(v, 0xB1, 0xf);
    DPP_ADD_(v, 0x4E, 0xf);
    DPP_ADD_(v, 0x141, 0xf);
    DPP_ADD_(v, 0x140, 0xf);
    DPP_ADD_(v, 0x142, 0xa);
    DPP_ADD_(v, 0x143, 0xc);
    return rdlane(v, 63);
}
__device__ __forceinline__ float sigmoidf_(float x) { return __builtin_amdgcn_rcpf(1.0f + __expf(-x)); }
__device__ __forceinline__ float siluf_(float x) { return x * __builtin_amdgcn_rcpf(1.0f + __expf(-x)); }
__device__ __forceinline__ float softplusf_(float x) { return x > 20.f ? x : log1pf(__expf(x)); }
__device__ __forceinline__ float gelu_tanh(float x) {
    const float y = 0.7978845608028654f * (x + 0.044715f * x * x * x);
    const float e = __expf(2.0f * y);
    const float th = 1.0f - 2.0f * __builtin_amdgcn_rcpf(e + 1.0f);
    return 0.5f * x * (1.0f + th);
}
#define LDS_FENCE() asm volatile("s_waitcnt lgkmcnt(0)" ::: "memory")
__device__ __forceinline__ void unpack8(const u32x4& a, float (&f)[8]) {
    f[0] = bf2f(a.x & 0xffff); f[1] = bf2f(a.x >> 16); f[2] = bf2f(a.y & 0xffff); f[3] = bf2f(a.y >> 16); f[4] = bf2f(a.z & 0xffff); f[5] = bf2f(a.z >> 16); f[6] = bf2f(a.w & 0xffff); f[7] = bf2f(a.w >> 16);
}

typedef unsigned long long ssq_t;
__device__ __forceinline__ ssq_t ss_fix(float s) { return (ssq_t)(s * 16777216.f); }
__device__ __forceinline__ float ss_rs(const ssq_t* ss, int row) { return rsqrtf((float)ss[row] * (1.f / (16777216.f * DM)) + EPS); }

#define XB_TMO      128
#define XB_XCNT(j)  (256  + 64 * (j))
#define XB_XSUB(j)  (1280 + 64 * (j))
#define XB_XGEN(j)  (2304 + 64 * (j))
#define XB_TOP      3328
#define XB_TOPGEN   3392
#define XCD_BAR_WORDS 3456
#define XB_SPIN_CAP (1u << 18)
__device__ __forceinline__ unsigned xb_ld(unsigned* p)              { return __hip_atomic_load(p, __ATOMIC_RELAXED, __HIP_MEMORY_SCOPE_AGENT); }
__device__ __forceinline__ unsigned xb_add(unsigned* p, unsigned v) { return __hip_atomic_fetch_add(p, v, __ATOMIC_RELAXED, __HIP_MEMORY_SCOPE_AGENT); }
__device__ __forceinline__ unsigned xb_xcc_id() { return (unsigned)__builtin_amdgcn_s_getreg((3 << 11) | 20) & 0xFu; }
#define XB_SPIN(cond, bar) do { unsigned _sp = 0; while (cond) { __builtin_amdgcn_s_sleep(1); \
    if ((++_sp & 255u) == 0u) { if (xb_ld(&(bar)[XB_TMO])) break; if (_sp > XB_SPIN_CAP) { atomicAdd(&(bar)[XB_TMO], 1u); break; } } } } while (0)
struct XcdBarrier { unsigned* bar; unsigned x; volatile LAS unsigned* st; };
__device__ __forceinline__ XcdBarrier xcd_barrier_post(unsigned* bar, volatile LAS unsigned* st) {
    XcdBarrier b; b.bar = bar; b.x = xb_xcc_id(); b.st = st;
    if (threadIdx.x == 0) (void)xb_add(&bar[XB_XCNT(b.x)], 1u);
    return b;
}
__device__ __forceinline__ void xcd_barrier_complete(unsigned* bar, unsigned x, unsigned& nloc, unsigned& nx) {
    const unsigned G = gridDim.x * gridDim.y * gridDim.z;
    unsigned sum, cnt, mine, sp = 0u;
    for (;;) {
        sum = 0u; cnt = 0u; mine = 0u;
#pragma unroll
        for (unsigned j = 0; j < 16; ++j) { const unsigned c = xb_ld(&bar[XB_XCNT(j)]); sum += c; cnt += (c > 0u) ? 1u : 0u; mine = (j == x) ? c : mine; }
        if (sum == G) break;
        __builtin_amdgcn_s_sleep(1);
        if ((++sp & 255u) == 0u) { if (xb_ld(&bar[XB_TMO])) break; if (sp > XB_SPIN_CAP) { atomicAdd(&bar[XB_TMO], 1u); break; } }
    }
    nloc = mine > 0u ? mine : 1u; nx = cnt > 0u ? cnt : 1u;
}
__device__ __forceinline__ void xcd_barrier(const XcdBarrier& b) {
    asm volatile("s_waitcnt vmcnt(0)" ::: "memory");
    __syncthreads();
    if (threadIdx.x == 0) {
        unsigned* bar = b.bar;
        __builtin_amdgcn_s_waitcnt(0);
        unsigned nloc = b.st[0], nx = b.st[1];
        if (nloc == 0u) { xcd_barrier_complete(bar, b.x, nloc, nx); b.st[0] = nloc; b.st[1] = nx; }
        const unsigned old = xb_add(&bar[XB_XSUB(b.x)], 1u);
        const unsigned gen = old / nloc;
        if (old + 1u == (gen + 1u) * nloc) {
            __builtin_amdgcn_fence(__ATOMIC_RELEASE, "agent");
            asm volatile("s_waitcnt vmcnt(0)" ::: "memory");
            const unsigned og = xb_add(&bar[XB_TOP], 1u);
            const unsigned tg = og / nx;
            if (og + 1u == (tg + 1u) * nx) xb_add(&bar[XB_TOPGEN], 1u);
            else XB_SPIN(xb_ld(&bar[XB_TOPGEN]) == tg, bar);
            __builtin_amdgcn_fence(__ATOMIC_ACQUIRE, "agent");
            xb_add(&bar[XB_XGEN(b.x)], 1u);
            asm volatile("s_waitcnt vmcnt(0)" ::: "memory");
        } else {
            XB_SPIN(xb_ld(&bar[XB_XGEN(b.x)]) == gen, bar);
            __builtin_amdgcn_fence(__ATOMIC_ACQUIRE, "agent");
            asm volatile("s_waitcnt vmcnt(0)" ::: "memory");
        }
    }
    __syncthreads();
}

namespace pg8 {
constexpr int BM = 256, BK = 64, HALF = 128, HTB = HALF * BK * 2, STAGE_BYTES = 8 * HTB;
__host__ __device__ __forceinline__ int lds_byte(int r, int c) { const int st = (r >> 4) * 2 + (c >> 5), rr = r & 15, cc = c & 31, ob = rr * 64 + cc * 2; return st * 1024 + (ob ^ (((ob >> 9) & 1) << 5)); }
__host__ __device__ __forceinline__ void stage_rc(int b, int& R, int& C) { const int st = b / 1024, sb = b % 1024, swz = sb ^ (((sb >> 9) & 1) << 5); R = (st >> 1) * 16 + swz / 64; C = (st & 1) * 32 + (swz % 64) / 2; }
__host__ __device__ __forceinline__ int perm32(int rho) { const int n = rho >> 4, i = rho & 15; return 8 * (i >> 2) + 4 * n + (i & 3); }

struct GUnit { const char* A; const char* B; int nt, kind, row0, col0, aux; };

template <class Epi, class Sched>
__device__ __forceinline__ void gemm_phase(LAS unsigned char* lds, const int tid, const int ld, const Sched& S, const Epi& E, const int erep = 0) {
    const int wid = __builtin_amdgcn_readfirstlane(tid >> 6), lane = tid & 63, wr = wid >> 2, wc = wid & 3, fr = lane & 15, fq = lane >> 4;
    unsigned voffA[2], voffB[2];
#pragma unroll
    for (int i = 0; i < 2; ++i) { int R, C; stage_rc(tid * 16 + i * 8192, R, C); const int Rb = (R & ~31) + perm32(R & 31);
        voffA[i] = (unsigned)(R * ld + C) * 2u; voffB[i] = (unsigned)(Rb * ld + C) * 2u; }
    const size_t kstep = (size_t)(BK * 2);
    const size_t hstep = (size_t)HALF * ld * 2;
    const unsigned ldsw = (unsigned)wid * 1024u;
    const int aoff = lds_byte(wr * 64 + fr, fq * 8), boff = lds_byte(wc * 32 + fr, fq * 8);
#define PG8_SA(b, h) (((b) * 2 + (h)) * HTB)
#define PG8_SB(b, h) ((4 + (b) * 2 + (h)) * HTB)
#define PG8_STAGE(bufoff, gbase, voff) do { _Pragma("unroll") for (int _i = 0; _i < 2; ++_i) \
        __builtin_amdgcn_global_load_lds((const unsigned*)((const char*)(gbase) + (voff)[_i]), (LAS unsigned*)(lds + (bufoff) + ldsw + _i * 8192), 16, 0, 0); } while (0)
#define PG8_LDA(dst, b, h) do { _Pragma("unroll") for (int m = 0; m < 4; ++m) _Pragma("unroll") for (int k = 0; k < 2; ++k) dst[m][k] = *(const LAS bf16x8*)(lds + PG8_SA(b, h) + aoff + m * 2048 + k * 1024); } while (0)
#define PG8_LDB(dst, b, h) do { _Pragma("unroll") for (int n = 0; n < 2; ++n) _Pragma("unroll") for (int k = 0; k < 2; ++k) dst[n][k] = *(const LAS bf16x8*)(lds + PG8_SB(b, h) + boff + n * 2048 + k * 1024); } while (0)
#define PG8_MMA(ai, bj, At, Bt) do { __builtin_amdgcn_s_setprio(1); _Pragma("unroll") for (int m = 0; m < 4; ++m) _Pragma("unroll") for (int n = 0; n < 2; ++n) _Pragma("unroll") for (int k = 0; k < 2; ++k) \
        acc[ai][bj][m][n] = __builtin_amdgcn_mfma_f32_16x16x32_bf16(Bt[n][k], At[m][k], acc[ai][bj][m][n], 0, 0, 0); __builtin_amdgcn_s_setprio(0); } while (0)
#define PG8_WAIT_V(n) asm volatile("s_waitcnt vmcnt(" #n ")" ::: "memory")
#define PG8_WAIT_L(n) asm volatile("s_waitcnt lgkmcnt(" #n ")" ::: "memory")
#define PG8_BAR __builtin_amdgcn_s_barrier()
#define PG8_SCHED __builtin_amdgcn_sched_barrier(0)
    GUnit cur, nxt; int ui = 0;
    if (!S.next(0, cur)) return;
    f32x4 acc[2][2][4][2];
#pragma unroll
    for (int a = 0; a < 2; ++a)
#pragma unroll
        for (int b = 0; b < 2; ++b)
#pragma unroll
            for (int m = 0; m < 4; ++m)
#pragma unroll
                for (int n = 0; n < 2; ++n) acc[a][b][m][n] = (f32x4){0.f, 0.f, 0.f, 0.f};
    bf16x8 At[4][2], B0[2][2], B1[2][2];
    const char* cA = cur.A; const char* cB = cur.B;
    PG8_STAGE(PG8_SB(0, 0), cB, voffB); PG8_STAGE(PG8_SB(0, 1), cB + hstep, voffB); PG8_STAGE(PG8_SA(0, 0), cA, voffA); PG8_STAGE(PG8_SA(0, 1), cA + hstep, voffA);
    if (wr == 1) PG8_BAR;
    PG8_WAIT_V(2); PG8_BAR;
    PG8_STAGE(PG8_SB(1, 0), cB + kstep, voffB); PG8_STAGE(PG8_SA(1, 0), cA + kstep, voffA); PG8_STAGE(PG8_SB(1, 1), cB + hstep + kstep, voffB);
    PG8_WAIT_V(6); PG8_BAR;
    for (;;) {
        const bool has_next = S.next(ui + 1, nxt);
        const char* nA = has_next ? nxt.A : cA; const char* nB = has_next ? nxt.B : cB;
        const int nt = cur.nt;
        for (int t = 0; t < nt; t += 2) {
            const bool last = (t == nt - 2);
            const char* a1 = cA + (size_t)(t + 1) * kstep;
            const char* a2 = last ? nA : cA + (size_t)(t + 2) * kstep; const char* b2 = last ? nB : cB + (size_t)(t + 2) * kstep;
            const char* a3 = a2 + kstep; const char* b3 = b2 + kstep;
            PG8_LDB(B0, 0, 0); PG8_LDB(B1, 0, 1); PG8_SCHED; PG8_LDA(At, 0, 0); PG8_STAGE(PG8_SA(1, 1), a1 + hstep, voffA);
            PG8_WAIT_V(8); PG8_WAIT_L(0); PG8_BAR; PG8_MMA(0, 0, At, B0); PG8_MMA(0, 1, At, B1); PG8_BAR; PG8_SCHED;
            PG8_LDA(At, 0, 1); PG8_STAGE(PG8_SB(0, 0), b2, voffB); PG8_STAGE(PG8_SB(0, 1), b2 + hstep, voffB); PG8_STAGE(PG8_SA(0, 0), a2, voffA);
            PG8_WAIT_V(8); PG8_WAIT_L(0); PG8_BAR; PG8_MMA(1, 0, At, B0); PG8_MMA(1, 1, At, B1); PG8_BAR; PG8_SCHED;
            PG8_LDB(B0, 1, 0); PG8_LDB(B1, 1, 1); PG8_SCHED; PG8_LDA(At, 1, 0); PG8_STAGE(PG8_SA(0, 1), a2 + hstep, voffA);
            PG8_WAIT_V(8); PG8_WAIT_L(0); PG8_BAR; PG8_MMA(0, 0, At, B0); PG8_MMA(0, 1, At, B1); PG8_BAR; PG8_SCHED;
            PG8_LDA(At, 1, 1); PG8_STAGE(PG8_SB(1, 0), b3, voffB); PG8_STAGE(PG8_SB(1, 1), b3 + hstep, voffB); PG8_STAGE(PG8_SA(1, 0), a3, voffA);
            PG8_WAIT_V(8); PG8_WAIT_L(0); PG8_BAR; PG8_MMA(1, 0, At, B0); PG8_MMA(1, 1, At, B1); PG8_BAR; PG8_SCHED;
        }
        if (wr == 0) PG8_BAR;
        asm volatile("s_nop 15" ::: "memory");
        for (int e = 0; e <= erep; ++e) E(acc, cur, wr, wc, fr, fq, tid);
        if (!has_next) break;
#pragma unroll
        for (int a = 0; a < 2; ++a)
#pragma unroll
            for (int b = 0; b < 2; ++b)
#pragma unroll
                for (int m = 0; m < 4; ++m)
#pragma unroll
                    for (int n = 0; n < 2; ++n) acc[a][b][m][n] = (f32x4){0.f, 0.f, 0.f, 0.f};
        cur = nxt; cA = nA; cB = nB; ++ui;
        if (wr == 1) PG8_BAR;
    }
    PG8_WAIT_V(0);
    PG8_BAR;
#undef PG8_SA
#undef PG8_SB
#undef PG8_STAGE
#undef PG8_LDA
#undef PG8_LDB
#undef PG8_MMA
#undef PG8_WAIT_V
#undef PG8_WAIT_L
#undef PG8_BAR
#undef PG8_SCHED
}

typedef f32x4 Acc[2][2][4][2];
__device__ __forceinline__ u32x4 pack8(const f32x4& v0, const f32x4& v1) { return cvt8(v0[0], v0[1], v0[2], v0[3], v1[0], v1[1], v1[2], v1[3]); }

struct EpiBf16S {
    bf16_t* O; int ldc; const ssq_t* ss; int srow_off;
    __device__ __forceinline__ void operator()(const Acc& acc, const GUnit& u, int wr, int wc, int fr, int fq, int tid) const {
        const int row0 = u.row0 + wr * 64 + fr, col0 = u.col0 + wc * 32 + 8 * fq;
#pragma unroll
        for (int ai = 0; ai < 2; ++ai)
#pragma unroll
            for (int m = 0; m < 4; ++m) { const int row = row0 + ai * HALF + m * 16; bf16_t* rowp = O + (size_t)row * ldc + col0;
                const float rs = ss ? ss_rs(ss, srow_off + row) : 1.f;
#pragma unroll
                for (int bj = 0; bj < 2; ++bj) *(u32x4*)(rowp + bj * HALF) = pack8(acc[ai][bj][m][0] * rs, acc[ai][bj][m][1] * rs); }
    }
};
struct EpiZ {
    bf16_t* Z; float* Zs; const ssq_t* ss;
    __device__ __forceinline__ void operator()(const Acc& acc, const GUnit& u, int wr, int wc, int fr, int fq, int tid) const {
        const int row0 = u.row0 + wr * 64 + fr;
        if (u.kind == 0) {
            const int col0 = u.col0 + wc * 32 + 8 * fq;
#pragma unroll
            for (int ai = 0; ai < 2; ++ai)
#pragma unroll
                for (int m = 0; m < 4; ++m) { const int row = row0 + ai * HALF + m * 16; bf16_t* rowp = Z + (size_t)row * NZ + col0;
                    const float rs = ss_rs(ss, row);
#pragma unroll
                    for (int bj = 0; bj < 2; ++bj) *(u32x4*)(rowp + bj * HALF) = pack8(acc[ai][bj][m][0] * rs, acc[ai][bj][m][1] * rs); }
        } else if (wc < 2) {
#pragma unroll
            for (int ai = 0; ai < 2; ++ai)
#pragma unroll
                for (int m = 0; m < 4; ++m) { const int row = row0 + ai * HALF + m * 16; float* p = Zs + (size_t)row * NZS + wc * 32 + 8 * fq;
                    const float rs = ss_rs(ss, row);
                    *(f32x4*)p = acc[ai][0][m][0] * rs; *(f32x4*)(p + 4) = acc[ai][0][m][1] * rs; }
        }
    }
};
struct EpiRes {
    const float* Xin32; float* Xout32; bf16_t* Xb; ssq_t* ss;
    __device__ __forceinline__ void operator()(const Acc& acc, const GUnit& u, int wr, int wc, int fr, int fq, int tid) const {
        const int row0 = u.row0 + wr * 64 + fr, col0 = u.col0 + wc * 32 + 8 * fq;
#pragma unroll
        for (int ai = 0; ai < 2; ++ai)
#pragma unroll
            for (int m = 0; m < 4; ++m) { const int row = row0 + ai * HALF + m * 16; const size_t off = (size_t)row * DM + col0;
                float sq = 0.f;
#pragma unroll
                for (int bj = 0; bj < 2; ++bj) {
                    f32x4 v0, v1;
                    if (Xin32) { v0 = *(const f32x4*)(Xin32 + off + bj * HALF); v1 = *(const f32x4*)(Xin32 + off + bj * HALF + 4); }
                    else { float f[8]; const u32x4 t = *(const u32x4*)(Xb + off + bj * HALF); unpack8(t, f); v0 = (f32x4){f[0], f[1], f[2], f[3]}; v1 = (f32x4){f[4], f[5], f[6], f[7]}; }
                    v0 += acc[ai][bj][m][0]; v1 += acc[ai][bj][m][1];
                    sq += (v0[0] * v0[0] + v0[1] * v0[1]) + (v0[2] * v0[2] + v0[3] * v0[3]) + (v1[0] * v1[0] + v1[1] * v1[1]) + (v1[2] * v1[2] + v1[3] * v1[3]);
                    if (Xout32) { *(f32x4*)(Xout32 + off + bj * HALF) = v0; *(f32x4*)(Xout32 + off + bj * HALF + 4) = v1; }
                    else *(u32x4*)(Xb + off + bj * HALF) = pack8(v0, v1);
                }
                sq += __shfl_xor(sq, 16); sq += __shfl_xor(sq, 32);
                if (fq == 0) atomicAdd(ss + row, ss_fix(sq));
            }
    }
};
struct EpiY {
    bf16_t* Y; const float* bg; const ssq_t* ss; __amdgpu_buffer_rsrc_t rs;
    __device__ __forceinline__ void operator()(const Acc& acc, const GUnit& u, int wr, int wc, int fr, int fq, int tid) const {
        const int voff = tid * 8;
        if (u.kind == 0) {
            const int br = u.aux;
#pragma unroll
            for (int ai = 0; ai < 2; ++ai)
#pragma unroll
                for (int m = 0; m < 4; ++m)
#pragma unroll
                    for (int bj = 0; bj < 2; ++bj) { const u32x4 w = pack8(acc[ai][bj][m][0], acc[ai][bj][m][1]);
                        const int idx = ((br * 2 + ai) * 4 + m) * 4 + 2 * bj;
                        __builtin_amdgcn_raw_buffer_store_b64((u32x2){w.x, w.y}, rs, voff, idx * 4096, 0); __builtin_amdgcn_raw_buffer_store_b64((u32x2){w.z, w.w}, rs, voff, (idx + 1) * 4096, 0); }
        } else {
            const int j4 = u.aux, row0 = u.row0 + wr * 64 + fr, ycol = u.col0 + 64 * j4 + 16 * wc + 4 * fq;
            f32x4 bia[2][2];
#pragma unroll
            for (int bj = 0; bj < 2; ++bj)
#pragma unroll
                for (int n = 0; n < 2; ++n) bia[bj][n] = *(const f32x4*)(bg + (2 * bj + n) * DM + ycol);
#pragma unroll
            for (int ai = 0; ai < 2; ++ai)
#pragma unroll
                for (int m = 0; m < 4; ++m) {
                    const int row = row0 + ai * HALF + m * 16;
                    const float rn = ss_rs(ss, row);
                    f32x4 y = (f32x4){0.f, 0.f, 0.f, 0.f};
#pragma unroll
                    for (int bj = 0; bj < 2; ++bj)
#pragma unroll
                        for (int n = 0; n < 2; ++n) { const int br = 2 * bj + n;
                            const u32x2 w = __builtin_amdgcn_raw_buffer_load_b64(rs, voff, ((((br * 2 + ai) * 4 + m) * 4) + j4) * 4096, 0);
                            const f32x4 a = acc[ai][bj][m][n] * rn + bia[bj][n];
                            y[0] += sigmoidf_(a[0]) * __uint_as_float(w.x << 16); y[1] += sigmoidf_(a[1]) * __uint_as_float(w.x & 0xffff0000u);
                            y[2] += sigmoidf_(a[2]) * __uint_as_float(w.y << 16); y[3] += sigmoidf_(a[3]) * __uint_as_float(w.y & 0xffff0000u); }
                    u32x2 o; o.x = pk2(y[0], y[1]); o.y = pk2(y[2], y[3]);
                    *(u32x2*)(Y + (size_t)row * DM + ycol) = o;
                    asm volatile("" ::: "memory");
                }
        }
    }
};

struct EpiUp {
    bf16_t* ACT; const ssq_t* ss; const float* cw; const float* cb; float* stash; LAS unsigned char* ul;
    __device__ __forceinline__ static int uoff(int row, int chunk) { return row * 256 + ((chunk ^ (row & 15)) << 4); }
    __device__ __forceinline__ static void ld8(LAS unsigned char* p, float (&f)[8]) { const u32x4 t = *(const LAS u32x4*)p; unpack8(t, f); }
    __device__ __forceinline__ void operator()(const Acc& acc, const GUnit& u, int wr, int wc, int fr, int fq, int tid) const {
        asm volatile("" : "+v"(fr), "+v"(fq));
        const int j = u.col0 >> 8, pmg = u.row0 >> 8, chunk = 4 * wc + fq, cbase = 128 * j + 32 * wc + 8 * fq;
        float* st = stash + ((size_t)(pmg * 22 + j) * 6) * 128 + 32 * wc + 8 * fq;
        float h1[8], h2[8];
#pragma unroll
        for (int e = 0; e < 8; ++e) { h1[e] = 0.f; h2[e] = 0.f; }
#pragma unroll
        for (int ai = 0; ai < 2; ++ai) {
            float rsr[4];
#pragma unroll
            for (int m = 0; m < 4; ++m) { const int r = 64 * wr + 16 * m + fr;
                rsr[m] = ss_rs(ss, u.row0 + ai * HALF + r);
                *(LAS u32x4*)(ul + uoff(r, chunk)) = pack8(acc[ai][0][m][0] * rsr[m], acc[ai][0][m][1] * rsr[m]); }
            asm volatile("s_waitcnt lgkmcnt(0)" ::: "memory"); __builtin_amdgcn_s_barrier(); asm volatile("" ::: "memory");
#pragma unroll
            for (int m = 0; m < 4; ++m) { const int r = 64 * wr + 16 * m + fr;
                float cu[8], p1[8], p2[8];
                ld8(ul + uoff(r, chunk), cu); ld8(ul + uoff((r - 1) & 127, chunk), p1); ld8(ul + uoff((r - 2) & 127, chunk), p2);
                if (ai == 1 && r == 0) {
#pragma unroll
                    for (int e = 0; e < 8; ++e) { p1[e] = h1[e]; p2[e] = h2[e]; } }
                if (ai == 1 && r == 1) {
#pragma unroll
                    for (int e = 0; e < 8; ++e) p2[e] = h1[e]; }
                const f32x4 v0 = acc[ai][1][m][0] * rsr[m], v1 = acc[ai][1][m][1] * rsr[m];
                float o[8];
#pragma unroll
                for (int hh = 0; hh < 2; ++hh) {
                    const f32x4 a0 = *(const f32x4*)(cw + cbase + 4 * hh), a1 = *(const f32x4*)(cw + DFF + cbase + 4 * hh), a2 = *(const f32x4*)(cw + 2 * DFF + cbase + 4 * hh), bq = *(const f32x4*)(cb + cbase + 4 * hh);
#pragma unroll
                    for (int e = 0; e < 4; ++e) { const float x = a0[e] * p2[4 * hh + e] + a1[e] * p1[4 * hh + e] + a2[e] * cu[4 * hh + e] + bq[e]; o[4 * hh + e] = gelu_tanh(x) * (hh ? v1[e] : v0[e]); } }
                *(u32x4*)(ACT + (size_t)(u.row0 + ai * HALF + r) * DFF + cbase) = cvt8(o[0], o[1], o[2], o[3], o[4], o[5], o[6], o[7]);
                if (ai == 0 && r < 2) {
                    *(f32x4*)(st + r * 128) = (f32x4){cu[0], cu[1], cu[2], cu[3]}; *(f32x4*)(st + r * 128 + 4) = (f32x4){cu[4], cu[5], cu[6], cu[7]};
                    *(f32x4*)(st + (4 + r) * 128) = v0; *(f32x4*)(st + (4 + r) * 128 + 4) = v1; }
                if (ai == 1 && r >= 126) {
                    *(f32x4*)(st + (r - 124) * 128) = (f32x4){cu[0], cu[1], cu[2], cu[3]}; *(f32x4*)(st + (r - 124) * 128 + 4) = (f32x4){cu[4], cu[5], cu[6], cu[7]}; }
                asm volatile("" ::: "memory");
            }
            if (ai == 0) { ld8(ul + uoff(127, chunk), h1); ld8(ul + uoff(126, chunk), h2); }
            asm volatile("s_waitcnt lgkmcnt(0)" ::: "memory"); __builtin_amdgcn_s_barrier(); asm volatile("" ::: "memory");
        }
    }
};

struct SchedPanel {
    const char* A; const char* B; int ld, nt, nN, pm, row0, pn0;
    __device__ __forceinline__ bool next(int i, GUnit& u) const {
        if (i >= nN) return false;
        const int pn = pn0 + i;
        u.A = A + (size_t)pm * 256 * ld * 2; u.B = B + (size_t)pn * 256 * ld * 2; u.nt = nt; u.kind = 0; u.row0 = row0; u.col0 = pn * 256; u.aux = 0; return true;
    }
};
struct SchedZ {
    const char* A; const char* B; int pm;
    __device__ __forceinline__ bool next(int i, GUnit& u) const {
        if (i >= 13) return false;
        u.A = A + (size_t)pm * 256 * DM * 2; u.B = B + (size_t)i * 256 * DM * 2; u.nt = 16; u.kind = (i == 12) ? 1 : 0; u.row0 = pm * 256; u.col0 = i * 256; u.aux = 0; return true;
    }
};
struct SchedY {
    const char* H; const char* O; const char* WbT; const char* WgT; int pm;
    __device__ __forceinline__ bool next(int i, GUnit& u) const {
        if (i >= 32) return false;
        const int pn = i >> 3, br = (i >> 1) & 3, kind = i & 1;
        u.kind = kind; u.aux = br; u.row0 = pm * 256; u.col0 = pn * 256;
        if (kind == 0) { u.A = O + (size_t)pm * 256 * DM * 2 + br * 256 * 2; u.B = WbT + (size_t)pn * 256 * DM * 2 + br * 256 * 2; u.nt = 4; }
        else { u.A = H + (size_t)pm * 256 * DM * 2; u.B = WgT + (size_t)(br * 1024 + pn * 256) * DM * 2; u.nt = 16; }
        return true;
    }
};
struct SchedG {
    const char* A; const char* B; int ld, nt, nN, np, gp, a_panel0, o_panel0, xcd, w, lastkind, hot;
    __device__ __forceinline__ bool next(int i, GUnit& u) const {
        const int idx = i * 32 + w;
        if (idx >= np * nN) return false;
        const int q = idx / (gp * nN), v = idx % (gp * nN), ntile = v / gp, pl = xcd * np + (hot ? 0 : q * gp) + v % gp;
        u.A = A + (size_t)(a_panel0 + pl) * 256 * ld * 2; u.B = B + (size_t)ntile * 256 * ld * 2; u.nt = nt;
        u.kind = (lastkind && ntile == nN - 1) ? 1 : 0; u.row0 = (o_panel0 + pl) * 256; u.col0 = ntile * 256; u.aux = 0; return true;
    }
};
struct SchedY2 {
    const char* H; const char* O; const char* WbT; const char* WgT; int xcd, w;
    __device__ __forceinline__ bool next(int i, GUnit& u) const {
        if (i >= 32) return false;
        const int pm = xcd * 32 + (i >> 3) * 8 + (w & 7), pn = w >> 3, kind = (i >> 2) & 1, idx = i & 3;
        u.kind = kind; u.aux = idx; u.row0 = pm * 256; u.col0 = pn * 256;
        if (kind == 0) { u.A = O + (size_t)pm * 256 * DM * 2 + idx * 256 * 2; u.B = WbT + (size_t)pn * 256 * DM * 2 + idx * 256 * 2; u.nt = 4; }
        else { u.A = H + (size_t)pm * 256 * DM * 2; u.B = WgT + (size_t)((pn * 4 + idx) * 256) * DM * 2; u.nt = 16; }
        return true;
    }
};
struct SchedOne {
    const char* A; const char* B; int nt, row0, col0;
    __device__ __forceinline__ bool next(int i, GUnit& u) const {
        if (i >= 1) return false;
        u.A = A; u.B = B; u.nt = nt; u.kind = 0; u.row0 = row0; u.col0 = col0; u.aux = 0; return true;
    }
};
}

__device__ __forceinline__ int srccol(int map, int r) {
    if (map == 0) return r;
    if (map == 1) {
        if (r < 1024) return r;
        if (r < 1792) return r + 16;
        if (r < 3072) return r + 24;
        if (r < 3088) return 1024 + (r - 3072);
        if (r < 3096) return 1808 + (r - 3088);
        if (r < 3108) return r;
        return -1;
    }
    if (map == 2) {
        const int j = r >> 8, w = r & 255;
        return w < 128 ? 128 * j + w : DFF + 128 * j + (w - 128); }
    const int c = r & 255, bj = c >> 7, wc = (c >> 5) & 3, fq = (c >> 3) & 3, n = (c >> 2) & 1, e = c & 3;
    if (map == 4) return (r & ~255) + 64 * (2 * bj + n) + 16 * wc + 4 * fq + e;
    const int unit = r >> 8, pn = unit >> 2, j4 = unit & 3;
    return (2 * bj + n) * (DM * DM) + 256 * pn + 64 * j4 + 16 * wc + 4 * fq + e;
}
__device__ __forceinline__ void tr_item(const float* W, int ldw, bf16_t* WT, int ldd, int dk0, int map, int r_off, int nkb, int item, const float* gk, LAS float* scr, int lane) {
    const int rb = item / nkb, kb = item % nkb, k0 = 32 * kb, r0 = 64 * rb;
    const int g = lane & 15, kq = lane >> 4;
    const int sc = srccol(map, r_off + r0 + 4 * g);
#pragma unroll
    for (int i = 0; i < 8; ++i) { const int kk = 4 * i + kq;
        f32x4 v = sc >= 0 ? *(const f32x4*)(W + (size_t)(k0 + kk) * ldw + sc) : (f32x4){0.f, 0.f, 0.f, 0.f};
        if (gk) v = v * gk[k0 + kk];
        scr[kk * 65 + 4 * g] = v[0]; scr[kk * 65 + 4 * g + 1] = v[1]; scr[kk * 65 + 4 * g + 2] = v[2]; scr[kk * 65 + 4 * g + 3] = v[3]; }
    LDS_FENCE();
    bf16_t* dp = WT + (size_t)(r0 + lane) * ldd + dk0 + k0;
#pragma unroll
    for (int c = 0; c < 4; ++c) { const LAS float* sp = scr + (8 * c) * 65 + lane;
        *(u32x4*)(dp + 8 * c) = cvt8(sp[0], sp[65], sp[2 * 65], sp[3 * 65], sp[4 * 65], sp[5 * 65], sp[6 * 65], sp[7 * 65]); }
    LDS_FENCE();
}
struct Args { const float* in[31]; float* out; unsigned char* ws; int ph_lo, ph_hi, use_bar, rep_gemm, rep_mix, rep_mem; };
struct TrJob { const float* W; const float* gk; int ldw; bf16_t* WT; int ldd, dk0, map, nkb, nitems, r_off; };
__device__ __forceinline__ TrJob tr_job(const Args& args, unsigned char* ws, int l, int j) {
    unsigned char* wb = ws + WS_W + (size_t)l * W_STRIDE;
    TrJob q; q.dk0 = 0; q.map = 0; q.r_off = 0; q.gk = nullptr;
    if (j < 5) q.gk = args.in[2] + (size_t)l * DM; else if (j == 10) q.gk = args.in[20] + (size_t)l * DM; else if (j == 13) q.gk = args.in[25] + (size_t)l * DM;
    if (j == 0) { q.W = args.in[3] + (size_t)l * DM * 3108; q.ldw = 3108; q.WT = (bf16_t*)(wb + WO_IN); q.ldd = DM; q.map = 1; q.nkb = 32; q.nitems = (NWIN / 64) * 32; }
    else if (j < 5) { const int i = j - 1; q.W = args.in[17] + (size_t)l * 4 * DM * DM; q.ldw = DM; q.WT = (bf16_t*)(wb + WO_G) + (size_t)i * DM * DM; q.ldd = DM; q.map = 3; q.nkb = 32; q.nitems = 16 * 32; q.r_off = i * 1024; }
    else if (j < 9) { const int i = j - 5; q.W = args.in[16] + ((size_t)l * 4 + i) * 256 * DM; q.ldw = DM; q.WT = (bf16_t*)(wb + WO_B); q.ldd = DM; q.dk0 = 256 * i; q.map = 4; q.nkb = 8; q.nitems = 16 * 8; }
    else if (j == 9) { q.W = args.in[19] + (size_t)l * DM * DM; q.ldw = DM; q.WT = (bf16_t*)(wb + WO_OUT); q.ldd = DM; q.nkb = 32; q.nitems = 16 * 32; }
    else if (j == 10) { q.W = args.in[22] + (size_t)l * DM * 512; q.ldw = 512; q.WT = (bf16_t*)(wb + WO_XQ); q.ldd = DM; q.nkb = 32; q.nitems = 8 * 32; }
    else if (j == 11) { q.W = args.in[23] + (size_t)l * DM * DM; q.ldw = DM; q.WT = (bf16_t*)(wb + WO_KV); q.ldd = DM; q.nkb = 32; q.nitems = 16 * 32; }
    else if (j == 12) { q.W = args.in[24] + (size_t)l * 512 * DM; q.ldw = DM; q.WT = (bf16_t*)(wb + WO_XO); q.ldd = 512; q.nkb = 16; q.nitems = 16 * 16; }
    else if (j == 13) { q.W = args.in[26] + (size_t)l * DM * NUP; q.ldw = NUP; q.WT = (bf16_t*)(wb + WO_UP); q.ldd = DM; q.map = 2; q.nkb = 32; q.nitems = (NUP / 64) * 32; }
    else if (j == 14) { q.W = args.in[29] + (size_t)l * DFF * DM; q.ldw = DM; q.WT = (bf16_t*)(wb + WO_DN); q.ldd = DFF; q.nkb = 88; q.nitems = 16 * 88; }
    else { const int kv = (j - 15) >> 1, hf = (j - 15) & 1;
        q.W = args.in[14] + ((size_t)l * 2 + kv) * 2048 * 64 + (size_t)hf * 1024 * 64; q.ldw = 64; q.WT = (bf16_t*)(wb + WO_C1) + ((size_t)kv * 128 + hf * 64) * 1024; q.ldd = 1024; q.nkb = 32; q.nitems = 1 * 32; }
    return q;
}

__device__ __forceinline__ void rms_row_bf16(const float* xrow, const float* g, bf16_t* orow, int lane) {
    const f32x4* xr = (const f32x4*)xrow + lane; const f32x4* gr = (const f32x4*)g + lane;
    f32x4 v[4]; float s = 0.f;
#pragma unroll
    for (int j = 0; j < 4; ++j) { v[j] = xr[64 * j]; s += (v[j].x * v[j].x + v[j].y * v[j].y) + (v[j].z * v[j].z + v[j].w * v[j].w); }
    const float rs = rsqrtf(wave_sum(s) * (1.f / DM) + EPS);
    unsigned long long* o8 = (unsigned long long*)orow + lane;
#pragma unroll
    for (int j = 0; j < 4; ++j) { const f32x4 gg = gr[64 * j];
        o8[64 * j] = (unsigned long long)pk2(v[j].x * rs * gg.x, v[j].y * rs * gg.y) | ((unsigned long long)pk2(v[j].z * rs * gg.z, v[j].w * rs * gg.w) << 32); }
}
__device__ __forceinline__ void xg_row_bf16(const float* xrow, const float* g, bf16_t* orow, ssq_t* ssq, int lane) {
    const f32x4* xr = (const f32x4*)xrow + lane; const f32x4* gr = (const f32x4*)g + lane;
    f32x4 v[4]; float s = 0.f;
#pragma unroll
    for (int j = 0; j < 4; ++j) { v[j] = xr[64 * j]; s += (v[j].x * v[j].x + v[j].y * v[j].y) + (v[j].z * v[j].z + v[j].w * v[j].w); }
    s = wave_sum(s);
    if (lane == 0) *ssq = ss_fix(s);
    unsigned long long* o8 = (unsigned long long*)orow + lane;
#pragma unroll
    for (int j = 0; j < 4; ++j) { const f32x4 gg = g ? gr[64 * j] : (f32x4){1.f, 1.f, 1.f, 1.f};
        o8[64 * j] = (unsigned long long)pk2(v[j].x * gg.x, v[j].y * gg.y) | ((unsigned long long)pk2(v[j].z * gg.z, v[j].w * gg.w) << 32); }
}
__device__ __forceinline__ void rms_row_f32(float* xrow, const float* g, int lane) {
    f32x4* xr = (f32x4*)xrow + lane; const f32x4* gr = (const f32x4*)g + lane;
    f32x4 v[4]; float s = 0.f;
#pragma unroll
    for (int j = 0; j < 4; ++j) { v[j] = xr[64 * j]; s += (v[j].x * v[j].x + v[j].y * v[j].y) + (v[j].z * v[j].z + v[j].w * v[j].w); }
    const float rs = rsqrtf(wave_sum(s) * (1.f / DM) + EPS);
#pragma unroll
    for (int j = 0; j < 4; ++j) { const f32x4 gg = gr[64 * j]; xr[64 * j] = v[j] * rs * gg; }
}

__device__ __forceinline__ void tr64(const bf16_t* src, int lds_, bf16_t* dst, int ldd, LAS bf16_t* tile, int lane) {
    const u32x4* sp = (const u32x4*)(src + (size_t)lane * lds_);
#pragma unroll
    for (int c = 0; c < 8; ++c) { const u32x4 w = sp[c];
        tile[(8 * c + 0) * 72 + lane] = (bf16_t)(w.x & 0xffff); tile[(8 * c + 1) * 72 + lane] = (bf16_t)(w.x >> 16);
        tile[(8 * c + 2) * 72 + lane] = (bf16_t)(w.y & 0xffff); tile[(8 * c + 3) * 72 + lane] = (bf16_t)(w.y >> 16);
        tile[(8 * c + 4) * 72 + lane] = (bf16_t)(w.z & 0xffff); tile[(8 * c + 5) * 72 + lane] = (bf16_t)(w.z >> 16);
        tile[(8 * c + 6) * 72 + lane] = (bf16_t)(w.w & 0xffff); tile[(8 * c + 7) * 72 + lane] = (bf16_t)(w.w >> 16); }
    LDS_FENCE();
    u32x4* dp = (u32x4*)(dst + (size_t)lane * ldd);
#pragma unroll
    for (int c = 0; c < 8; ++c) dp[c] = *(const LAS u32x4*)(tile + lane * 72 + 8 * c);
    LDS_FENCE();
}

__device__ __forceinline__ void pool_item(const bf16_t* Z, bf16_t* O, const float* pw, const float* pscale, LAS float* wl, int b, int g, int t0, int lane) {
    asm volatile("" : "+v"(lane));
    float W[64];
#pragma unroll
    for (int c = 0; c < 64; ++c) W[c] = pw[(g * 64 + c) * 64 + lane];
    const float scale = pscale[g * 64 + lane];
    const int w = 2 << g;
    float hst[15];
#pragma unroll
    for (int k = 0; k < 15; ++k) { const int tt = t0 - 1 - k; hst[k] = tt >= 0 ? bf2f(Z[(size_t)(b * SEQ + tt) * NZ + ZC_POOL + g * 64 + lane]) : 0.f; }
    bf16_t n8[8];
#pragma unroll
    for (int i = 0; i < 8; ++i) n8[i] = Z[(size_t)(b * SEQ + t0 + i) * NZ + ZC_POOL + g * 64 + lane];
    for (int tb = 0; tb < 8; ++tb) {
        int rowi = b * SEQ + t0 + tb * 8; asm volatile("" : "+s"(rowi));
        float u8[8];
#pragma unroll
        for (int i = 0; i < 8; ++i) u8[i] = bf2f(n8[i]);
        if (tb < 7) {
#pragma unroll
            for (int i = 0; i < 8; ++i) n8[i] = Z[(size_t)(rowi + 8 + i) * NZ + ZC_POOL + g * 64 + lane]; }
#pragma unroll
        for (int i = 0; i < 8; ++i) {
            const int t = t0 + tb * 8 + i;
            const float u0 = u8[i];
            float sum = u0;
#pragma unroll
            for (int k = 0; k < 15; ++k) sum += (k + 1 < w) ? hst[k] : 0.f;
            const int cnt = (t + 1) < w ? (t + 1) : w;
            const float d = sum / (float)cnt - u0;
            wl[i * 64 + lane] = d;
#pragma unroll
            for (int k = 14; k > 0; --k) hst[k] = hst[k - 1];
            hst[0] = u0;
        }
        LDS_FENCE();
#pragma unroll 1
        for (int i = 0; i < 8; ++i) {
            float o = 0.f;
#pragma unroll
            for (int c = 0; c < 16; ++c) { const f32x4 d4 = *(const LAS f32x4*)(wl + i * 64 + 4 * c); o += d4[0] * W[4 * c] + d4[1] * W[4 * c + 1] + d4[2] * W[4 * c + 2] + d4[3] * W[4 * c + 3]; }
            O[(size_t)(rowi + i) * DM + g * 64 + lane] = (bf16_t)f2bf(o * scale);
        }
        LDS_FENCE();
    }
}

struct GlaRaw { float lr[2], q[4], k[4], v[8], r[8]; };
template <int MODE>
__device__ __forceinline__ void gla_load(GlaRaw& t, const bf16_t* Z, const float* Zs, int row0i, int h, int lane) {
    asm volatile("" : "+s"(row0i));
    const size_t row0 = (size_t)row0i;
#pragma unroll
    for (int rp = 0; rp < 2; ++rp) t.lr[rp] = Zs[(row0 + rp * 4 + (lane >> 4)) * NZS + ZS_LR + (lane & 15)];
#pragma unroll
    for (int rp = 0; rp < 4; ++rp) { const bf16_t* zr = Z + (row0 + rp * 2 + (lane >> 5)) * NZ; t.q[rp] = bf2f(zr[ZC_AQ + h * 32 + (lane & 31)]); t.k[rp] = bf2f(zr[ZC_AK + h * 32 + (lane & 31)]); }
#pragma unroll
    for (int i = 0; i < 8; ++i) { const bf16_t* zr = Z + (row0 + i) * NZ; t.v[i] = bf2f(zr[ZC_AV + h * 64 + lane]); t.r[i] = (MODE == 3) ? bf2f(zr[ZC_AR + h * 64 + lane]) : 0.f; }
}
template <int MODE>
__device__ __forceinline__ void gla_chunk(const bf16_t* Z, const float* Zs, bf16_t* O, const float* w_lr, const float* b_lr, const float* gnorm,
                                          float* Sbuf, float* Dbuf, LAS float* wl, int b, int h, int n, int lane) {
    asm volatile("" : "+v"(lane));
    float wlr[16];
#pragma unroll
    for (int j = 0; j < 16; ++j) wlr[j] = w_lr[j * 128 + h * 32 + (lane & 31)];
    const float bl = b_lr[h * 32 + (lane & 31)], gn = gnorm[lane];
    const size_t chunk = ((size_t)b * 4 + h) * 32 + n;
    float S[32];
#pragma unroll
    for (int d = 0; d < 32; ++d) S[d] = (MODE == 3) ? Sbuf[chunk * 2048 + d * 64 + lane] : 0.f;
    float Dc = 1.f;
    GlaRaw t;
    gla_load<MODE>(t, Z, Zs, b * SEQ + n * 64, h, lane);
    for (int sb = 0; sb < 8; ++sb) {
        int row0i = b * SEQ + n * 64 + sb * 8; asm volatile("" : "+s"(row0i)); const size_t row0 = (size_t)row0i;
#pragma unroll
        for (int rp = 0; rp < 2; ++rp) wl[rp * 64 + lane] = t.lr[rp];
#pragma unroll
        for (int rp = 0; rp < 4; ++rp) { wl[128 + rp * 64 + lane] = t.q[rp] * 0.17677669529663687f; wl[384 + rp * 64 + lane] = t.k[rp]; }
#pragma unroll
        for (int i = 0; i < 8; ++i) { wl[896 + i * 64 + lane] = t.v[i]; if (MODE == 3) wl[1408 + i * 64 + lane] = t.r[i]; }
        if (sb < 7) gla_load<MODE>(t, Z, Zs, row0i + 8, h, lane);
        LDS_FENCE();
#pragma unroll
        for (int rp = 0; rp < 4; ++rp) {
            const int tok = rp * 2 + (lane >> 5);
            float x = bl;
#pragma unroll
            for (int c = 0; c < 4; ++c) { const f32x4 l4 = *(const LAS f32x4*)(wl + tok * 16 + 4 * c); x += l4[0] * wlr[4 * c] + l4[1] * wlr[4 * c + 1] + l4[2] * wlr[4 * c + 2] + l4[3] * wlr[4 * c + 3]; }
            const float ls = fminf(x, 0.f) - log1pf(__expf(-fabsf(x)));
            const float e = __expf(ls * (1.0f / 16.0f));
            Dc *= e;
            wl[640 + tok * 32 + (lane & 31)] = e;
        }
        LDS_FENCE();
#pragma unroll 2
        for (int i = 0; i < 8; ++i) {
            const float vi = wl[896 + i * 64 + lane];
            f32x4 o4 = (f32x4){0.f, 0.f, 0.f, 0.f};
#pragma unroll
            for (int c = 0; c < 8; ++c) {
                const f32x4 e4 = *(const LAS f32x4*)(wl + 640 + i * 32 + 4 * c), k4 = *(const LAS f32x4*)(wl + 384 + i * 32 + 4 * c);
#pragma unroll
                for (int j = 0; j < 4; ++j) S[4 * c + j] = S[4 * c + j] * e4[j] + k4[j] * vi;
                if (MODE == 3) { const f32x4 q4 = *(const LAS f32x4*)(wl + 128 + i * 32 + 4 * c);
#pragma unroll
                    for (int j = 0; j < 4; ++j) o4[j] += q4[j] * S[4 * c + j]; }
            }
            if (MODE == 3) wl[1920 + i * 64 + lane] = (o4[0] + o4[1]) + (o4[2] + o4[3]);
        }
        LDS_FENCE();
        if (MODE == 3) {
#pragma unroll
            for (int i = 0; i < 8; ++i) { const float o = wl[1920 + i * 64 + lane];
                const float rn = rsqrtf(wave_sum(o * o) * (1.f / 64.f) + EPS);
                O[(row0 + i) * DM + 256 + h * 64 + lane] = (bf16_t)f2bf(o * rn * gn * siluf_(wl[1408 + i * 64 + lane])); }
            LDS_FENCE();
        }
    }
    if (MODE == 1) {
#pragma unroll
        for (int d = 0; d < 32; ++d) Sbuf[chunk * 2048 + d * 64 + lane] = S[d];
        Dc *= __shfl_xor(Dc, 32);
        if (lane < 32) Dbuf[chunk * 32 + lane] = Dc;
    }
}
__device__ __forceinline__ void gla_scan(float* Sbuf, const float* Dbuf, int bh, int lane) {
    float S[32];
#pragma unroll
    for (int d = 0; d < 32; ++d) S[d] = 0.f;
    for (int n = 0; n < 32; ++n) {
        const size_t chunk = (size_t)bh * 32 + n;
        float Sl[32];
#pragma unroll
        for (int d = 0; d < 32; ++d) Sl[d] = Sbuf[chunk * 2048 + d * 64 + lane];
        float Dn[32];
#pragma unroll
        for (int d = 0; d < 32; ++d) Dn[d] = Dbuf[chunk * 32 + d];
#pragma unroll
        for (int d = 0; d < 32; ++d) { Sbuf[chunk * 2048 + d * 64 + lane] = S[d]; S[d] = Dn[d] * S[d] + Sl[d]; }
    }
}

struct GdnRaw { float k[8], v[8], q[8], g[8], ab; };
template <int MODE>
__device__ __forceinline__ void gdn_load(GdnRaw& t, const bf16_t* Z, const float* Zs, int row0i, int h, int lane) {
    asm volatile("" : "+s"(row0i));
    const size_t row0 = (size_t)row0i;
#pragma unroll
    for (int i = 0; i < 8; ++i) { const bf16_t* zr = Z + (row0 + i) * NZ;
        t.k[i] = bf2f(zr[ZC_DK + h * 64 + lane]); t.v[i] = bf2f(zr[ZC_DV + h * 64 + lane]);
        t.q[i] = (MODE == 3) ? bf2f(zr[ZC_DQ + h * 64 + lane]) : 0.f; t.g[i] = (MODE == 3) ? bf2f(zr[ZC_DG + h * 64 + lane]) : 0.f; }
    t.ab = Zs[(row0 + (lane & 7)) * NZS + ((lane & 8) ? ZS_DB : ZS_DA) + h];
}
template <int MODE>
__device__ __forceinline__ void gdn_chunk(const bf16_t* Z, const float* Zs, bf16_t* O, const float* convw, const float* a_log, const float* dt_bias, const float* gnorm,
                                          float* Sbuf, float* Pbuf, LAS float* wl, int b, int h, int n, int lane) {
    asm volatile("" : "+v"(lane));
    float cq[4], ck[4], cv[4];
#pragma unroll
    for (int i = 0; i < 4; ++i) { cq[i] = convw[i * 768 + h * 64 + lane]; ck[i] = convw[i * 768 + 256 + h * 64 + lane]; cv[i] = convw[i * 768 + 512 + h * 64 + lane]; }
    const float Aneg = -__expf(a_log[h]), dtb = dt_bias[h], gn = gnorm[lane];
    const size_t chunk = ((size_t)b * 4 + h) * 32 + n;
    const size_t rowc = (size_t)b * SEQ + n * 64;
    float q1 = 0.f, q2 = 0.f, q3 = 0.f, k1 = 0.f, k2 = 0.f, k3 = 0.f, v1 = 0.f, v2 = 0.f, v3 = 0.f;
    if (n > 0) { const bf16_t* z1 = Z + (rowc - 1) * NZ; const bf16_t* z2 = Z + (rowc - 2) * NZ; const bf16_t* z3 = Z + (rowc - 3) * NZ;
        k1 = bf2f(z1[ZC_DK + h * 64 + lane]); k2 = bf2f(z2[ZC_DK + h * 64 + lane]); k3 = bf2f(z3[ZC_DK + h * 64 + lane]);
        v1 = bf2f(z1[ZC_DV + h * 64 + lane]); v2 = bf2f(z2[ZC_DV + h * 64 + lane]); v3 = bf2f(z3[ZC_DV + h * 64 + lane]);
        if (MODE == 3) { q1 = bf2f(z1[ZC_DQ + h * 64 + lane]); q2 = bf2f(z2[ZC_DQ + h * 64 + lane]); q3 = bf2f(z3[ZC_DQ + h * 64 + lane]); } }
    float S[64], Phi[MODE == 1 ? 64 : 1];
#pragma unroll
    for (int d = 0; d < 64; ++d) S[d] = (MODE == 3) ? Sbuf[chunk * 4096 + d * 64 + lane] : 0.f;
    if (MODE == 1) {
#pragma unroll
        for (int d = 0; d < 64; ++d) Phi[MODE == 1 ? d : 0] = (d == lane) ? 1.f : 0.f; }
    GdnRaw t;
    gdn_load<MODE>(t, Z, Zs, (int)rowc, h, lane);
    for (int sb = 0; sb < 8; ++sb) {
        int row0i = (int)rowc + sb * 8; asm volatile("" : "+s"(row0i)); const size_t row0 = (size_t)row0i;
#pragma unroll
        for (int i = 0; i < 8; ++i) { wl[i * 64 + lane] = t.k[i]; wl[1024 + i * 64 + lane] = t.v[i]; if (MODE == 3) { wl[512 + i * 64 + lane] = t.q[i]; wl[1536 + i * 64 + lane] = t.g[i]; } }
        if (lane < 8) wl[2048 + lane] = __expf(Aneg * softplusf_(t.ab + dtb)); else if (lane < 16) wl[2048 + lane] = sigmoidf_(t.ab);
        if (sb < 7) gdn_load<MODE>(t, Z, Zs, row0i + 8, h, lane);
        LDS_FENCE();
#pragma unroll 2
        for (int i = 0; i < 8; ++i) {
            const float rk = wl[i * 64 + lane], rv = wl[1024 + i * 64 + lane];
            float xk = ck[0] * k3 + ck[1] * k2 + ck[2] * k1 + ck[3] * rk;
            const float xw = cv[0] * v3 + cv[1] * v2 + cv[2] * v1 + cv[3] * rv;
            k3 = k2; k2 = k1; k1 = rk; v3 = v2; v2 = v1; v1 = rv;
            xk = siluf_(xk);
            wl[i * 64 + lane] = xk * rsqrtf(wave_sum(xk * xk) + EPS);
            wl[1024 + i * 64 + lane] = siluf_(xw);
            if (MODE == 3) { const float rq = wl[512 + i * 64 + lane]; float xq = cq[0] * q3 + cq[1] * q2 + cq[2] * q1 + cq[3] * rq; q3 = q2; q2 = q1; q1 = rq; xq = siluf_(xq);
                wl[512 + i * 64 + lane] = xq * rsqrtf(wave_sum(xq * xq) + EPS) * 0.125f; }
        }
        LDS_FENCE();
#pragma unroll 1
        for (int i = 0; i < 8; ++i) {
            const float a = wl[2048 + i], bcf = wl[2056 + i], xvi = wl[1024 + i * 64 + lane];
            typedef float f32x2 __attribute__((ext_vector_type(2)));
            if (MODE == 3) {
                f32x4 kk[16];
#pragma unroll
                for (int c = 0; c < 16; ++c) kk[c] = *(const LAS f32x4*)(wl + i * 64 + 4 * c);
                f32x2 ks0 = (f32x2){0.f, 0.f}, ks1 = (f32x2){0.f, 0.f};
#pragma unroll
                for (int c = 0; c < 16; ++c) { ks0 += (f32x2){kk[c][0], kk[c][1]} * (f32x2){S[4 * c], S[4 * c + 1]}; ks1 += (f32x2){kk[c][2], kk[c][3]} * (f32x2){S[4 * c + 2], S[4 * c + 3]}; }
                const float kS = (ks0[0] + ks0[1]) + (ks1[0] + ks1[1]);
                const float vn = bcf * (xvi - a * kS);
                const f32x2 a2 = (f32x2){a, a}, v2 = (f32x2){vn, vn};
                f32x2 o0 = (f32x2){0.f, 0.f}, o1 = (f32x2){0.f, 0.f};
#pragma unroll
                for (int c = 0; c < 16; ++c) {
                    const f32x4 q4 = *(const LAS f32x4*)(wl + 512 + i * 64 + 4 * c);
                    f32x2 s0 = a2 * (f32x2){S[4 * c], S[4 * c + 1]} + (f32x2){kk[c][0], kk[c][1]} * v2, s1 = a2 * (f32x2){S[4 * c + 2], S[4 * c + 3]} + (f32x2){kk[c][2], kk[c][3]} * v2;
                    S[4 * c] = s0[0]; S[4 * c + 1] = s0[1]; S[4 * c + 2] = s1[0]; S[4 * c + 3] = s1[1];
                    o0 += (f32x2){q4[0], q4[1]} * s0; o1 += (f32x2){q4[2], q4[3]} * s1;
                    if ((c & 3) == 3) asm volatile("" ::: "memory");
                }
                wl[512 + i * 64 + lane] = (o0[0] + o0[1]) + (o1[0] + o1[1]);
            } else {
                float kSa = 0.f, kSb = 0.f, kPa = 0.f, kPb = 0.f;
#pragma unroll
                for (int c = 0; c < 16; ++c) { const f32x4 k4 = *(const LAS f32x4*)(wl + i * 64 + 4 * c);
                    kSa += k4[0] * S[4 * c]; kSb += k4[1] * S[4 * c + 1]; kSa += k4[2] * S[4 * c + 2]; kSb += k4[3] * S[4 * c + 3];
                    kPa += k4[0] * Phi[MODE == 1 ? 4 * c : 0]; kPb += k4[1] * Phi[MODE == 1 ? 4 * c + 1 : 0]; kPa += k4[2] * Phi[MODE == 1 ? 4 * c + 2 : 0]; kPb += k4[3] * Phi[MODE == 1 ? 4 * c + 3 : 0]; }
                const float kS = kSa + kSb, kP = kPa + kPb;
                const float vn = bcf * (xvi - a * kS), vp = -bcf * a * kP;
#pragma unroll
                for (int c = 0; c < 16; ++c) { const f32x4 k4 = *(const LAS f32x4*)(wl + i * 64 + 4 * c);
#pragma unroll
                    for (int j = 0; j < 4; ++j) { S[4 * c + j] = a * S[4 * c + j] + k4[j] * vn; Phi[MODE == 1 ? 4 * c + j : 0] = a * Phi[MODE == 1 ? 4 * c + j : 0] + k4[j] * vp; }
                    if ((c & 3) == 3) asm volatile("" ::: "memory");
                }
            }
        }
        LDS_FENCE();
        if (MODE == 3) {
#pragma unroll 2
            for (int i = 0; i < 8; ++i) { const float o = wl[512 + i * 64 + lane];
                const float rn = rsqrtf(wave_sum(o * o) * (1.f / 64.f) + EPS);
                O[(row0 + i) * DM + 512 + h * 64 + lane] = (bf16_t)f2bf(o * rn * gn * siluf_(wl[1536 + i * 64 + lane])); }
            LDS_FENCE();
        }
    }
    if (MODE == 1) {
#pragma unroll
        for (int d = 0; d < 64; ++d) { Sbuf[chunk * 4096 + d * 64 + lane] = S[d]; Pbuf[chunk * 4096 + d * 64 + lane] = Phi[MODE == 1 ? d : 0]; }
    }
}
__device__ __forceinline__ void gdn_scan_wg(float* Sbuf, const float* Pbuf, LAS float* wl, int bh, int wave, int lane) {
    float S[64];
#pragma unroll
    for (int d = 0; d < 64; ++d) S[d] = 0.f;
    const int d0 = 8 * wave;
    f32x4 pn[2]; float sl[8];
    { const size_t chunk = (size_t)bh * 32;
      const f32x4* pp = (const f32x4*)(Pbuf + chunk * 4096 + d0 * 64);
      pn[0] = pp[lane]; pn[1] = pp[64 + lane];
#pragma unroll
      for (int i = 0; i < 8; ++i) sl[i] = Sbuf[chunk * 4096 + (d0 + i) * 64 + lane]; }
    for (int n = 0; n < 32; ++n) {
        const size_t chunk = (size_t)bh * 32 + n;
        *(LAS f32x4*)(wl + wave * 512 + lane * 4) = pn[0]; *(LAS f32x4*)(wl + wave * 512 + 256 + lane * 4) = pn[1];
        float sc_[8];
#pragma unroll
        for (int i = 0; i < 8; ++i) { sc_[i] = sl[i]; Sbuf[chunk * 4096 + (d0 + i) * 64 + lane] = (n == 0) ? 0.f : wl[4096 + (d0 + i) * 64 + lane]; }
        if (n + 1 < 32) {
            const f32x4* pp = (const f32x4*)(Pbuf + (chunk + 1) * 4096 + d0 * 64);
            pn[0] = pp[lane]; pn[1] = pp[64 + lane];
#pragma unroll
            for (int i = 0; i < 8; ++i) sl[i] = Sbuf[(chunk + 1) * 4096 + (d0 + i) * 64 + lane];
        }
        LDS_FENCE();
#pragma unroll
        for (int i = 0; i < 8; ++i) {
            float acc = sc_[i];
#pragma unroll
            for (int c = 0; c < 16; ++c) { const f32x4 p4 = *(const LAS f32x4*)(wl + wave * 512 + i * 64 + 4 * c);
                acc += p4[0] * S[4 * c] + p4[1] * S[4 * c + 1] + p4[2] * S[4 * c + 2] + p4[3] * S[4 * c + 3]; }
            wl[4096 + (d0 + i) * 64 + lane] = acc;
        }
        LDS_FENCE();
        __syncthreads();
#pragma unroll
        for (int d = 0; d < 64; ++d) S[d] = wl[4096 + d * 64 + lane];
        LDS_FENCE();
        __syncthreads();
    }
}

typedef short s16x4 __attribute__((ext_vector_type(4)));
__device__ __forceinline__ f32x4 mfma16x32(bf16x8 a, bf16x8 b, f32x4 c) { return __builtin_amdgcn_mfma_f32_16x16x32_bf16(a, b, c, 0, 0, 0); }
__device__ __forceinline__ f32x4 mfma16x16(s16x4 a, s16x4 b, f32x4 c) { return __builtin_amdgcn_mfma_f32_16x16x16bf16_1k(a, b, c, 0, 0, 0); }
__device__ __forceinline__ s16x4 cvt4(float a0, float a1, float a2, float a3) {
    u32x2 p;
    asm("s_nop 11\n\tv_cvt_pk_bf16_f32 %0, %2, %3\n\tv_cvt_pk_bf16_f32 %1, %4, %5\n\ts_nop 1" : "=&v"(p[0]), "=&v"(p[1]) : "v"(a0), "v"(a1), "v"(a2), "v"(a3));
    return __builtin_bit_cast(s16x4, p);
}
__device__ __forceinline__ float row16_sum(float v) { DPP_ADD_(v, 0xB1, 0xf); DPP_ADD_(v, 0x4E, 0xf); DPP_ADD_(v, 0x141, 0xf); DPP_ADD_(v, 0x140, 0xf); return v; }
__device__ __forceinline__ float row16_scan(float v) {
    v += __int_as_float(__builtin_amdgcn_update_dpp(0, __float_as_int(v), 0x111, 0xf, 0xf, true));
    v += __int_as_float(__builtin_amdgcn_update_dpp(0, __float_as_int(v), 0x112, 0xf, 0xf, true));
    v += __int_as_float(__builtin_amdgcn_update_dpp(0, __float_as_int(v), 0x114, 0xf, 0xf, true));
    v += __int_as_float(__builtin_amdgcn_update_dpp(0, __float_as_int(v), 0x118, 0xf, 0xf, true));
    return v;
}

__device__ __forceinline__ void gdn_prep(const bf16_t* Z, const float* Zs, const float* convw, const float* a_log, const float* dt_bias,
                                         bf16_t* KT, bf16_t* QN, bf16_t* KN, bf16_t* XVT, float* AB, int b, int h, int n, int lane) {
    asm volatile("" : "+v"(lane));
    float cq[4], ck[4], cv[4];
#pragma unroll
    for (int i = 0; i < 4; ++i) { cq[i] = convw[i * 768 + h * 64 + lane]; ck[i] = convw[i * 768 + 256 + h * 64 + lane]; cv[i] = convw[i * 768 + 512 + h * 64 + lane]; }
    const float Aneg = -__expf(a_log[h]), dtb = dt_bias[h];
    const size_t rowc = (size_t)b * SEQ + n * 64;
    float q1 = 0.f, q2 = 0.f, q3 = 0.f, k1 = 0.f, k2 = 0.f, k3 = 0.f, v1 = 0.f, v2 = 0.f, v3 = 0.f;
    if (n > 0) { const bf16_t* z1 = Z + (rowc - 1) * NZ; const bf16_t* z2 = Z + (rowc - 2) * NZ; const bf16_t* z3 = Z + (rowc - 3) * NZ;
        k1 = bf2f(z1[ZC_DK + h * 64 + lane]); k2 = bf2f(z2[ZC_DK + h * 64 + lane]); k3 = bf2f(z3[ZC_DK + h * 64 + lane]);
        v1 = bf2f(z1[ZC_DV + h * 64 + lane]); v2 = bf2f(z2[ZC_DV + h * 64 + lane]); v3 = bf2f(z3[ZC_DV + h * 64 + lane]);
        q1 = bf2f(z1[ZC_DQ + h * 64 + lane]); q2 = bf2f(z2[ZC_DQ + h * 64 + lane]); q3 = bf2f(z3[ZC_DQ + h * 64 + lane]); }
    const size_t trow = (((size_t)b * 4 + h) * 64 + lane) * SEQ + n * 64;
    bf16_t nk[8], nv[8], nq[8]; float nab;
    { const size_t row0 = rowc;
#pragma unroll
      for (int i = 0; i < 8; ++i) { const bf16_t* zr = Z + (row0 + i) * NZ; nk[i] = zr[ZC_DK + h * 64 + lane]; nv[i] = zr[ZC_DV + h * 64 + lane]; nq[i] = zr[ZC_DQ + h * 64 + lane]; }
      nab = Zs[(row0 + (lane & 7)) * NZS + ((lane & 8) ? ZS_DB : ZS_DA) + h]; }
    for (int sb = 0; sb < 8; ++sb) {
        int row0i = (int)rowc + sb * 8; asm volatile("" : "+s"(row0i)); const size_t row0 = (size_t)row0i;
        float rk[8], rv[8], rq[8];
#pragma unroll
        for (int i = 0; i < 8; ++i) { rk[i] = bf2f(nk[i]); rv[i] = bf2f(nv[i]); rq[i] = bf2f(nq[i]); }
        const float ab = nab;
        if (sb < 7) { const size_t rown = row0 + 8;
#pragma unroll
            for (int i = 0; i < 8; ++i) { const bf16_t* zr = Z + (rown + i) * NZ; nk[i] = zr[ZC_DK + h * 64 + lane]; nv[i] = zr[ZC_DV + h * 64 + lane]; nq[i] = zr[ZC_DQ + h * 64 + lane]; }
            nab = Zs[(rown + (lane & 7)) * NZS + ((lane & 8) ? ZS_DB : ZS_DA) + h]; }
        float kk[8], qq[8], vv[8];
#pragma unroll
        for (int i = 0; i < 8; ++i) {
            float xk = ck[0] * k3 + ck[1] * k2 + ck[2] * k1 + ck[3] * rk[i];
            float xq = cq[0] * q3 + cq[1] * q2 + cq[2] * q1 + cq[3] * rq[i];
            const float xw = cv[0] * v3 + cv[1] * v2 + cv[2] * v1 + cv[3] * rv[i];
            k3 = k2; k2 = k1; k1 = rk[i]; q3 = q2; q2 = q1; q1 = rq[i]; v3 = v2; v2 = v1; v1 = rv[i];
            xk = siluf_(xk); xq = siluf_(xq);
            kk[i] = xk * rsqrtf(wave_sum(xk * xk) + EPS);
            qq[i] = xq * rsqrtf(wave_sum(xq * xq) + EPS) * 0.125f;
            vv[i] = siluf_(xw);
            KN[(row0 + i) * 256 + h * 64 + lane] = (bf16_t)f2bf(kk[i]); QN[(row0 + i) * 256 + h * 64 + lane] = (bf16_t)f2bf(qq[i]);
        }
        *(u32x4*)(KT + trow + sb * 8) = cvt8(kk[0], kk[1], kk[2], kk[3], kk[4], kk[5], kk[6], kk[7]);
        *(u32x4*)(XVT + trow + sb * 8) = cvt8(vv[0], vv[1], vv[2], vv[3], vv[4], vv[5], vv[6], vv[7]);
        if (lane < 8) AB[((row0 + lane) * 4 + h) * 2] = Aneg * softplusf_(ab + dtb);
        else if (lane < 16) AB[((row0 + lane - 8) * 4 + h) * 2 + 1] = sigmoidf_(ab);
    }
}

__device__ __forceinline__ void gdn_dma(LAS unsigned char* buf, const bf16_t* Z, const bf16_t* KT, const bf16_t* QN, const bf16_t* KN, const bf16_t* XVT, int b, int h, int blk, int lane) {
    asm volatile("" : "+s"(blk), "+v"(lane));
    const int c = lane & 15, qd = lane >> 4, bh = b * 4 + h;
    const size_t row0 = (size_t)b * SEQ + blk * 16;
    const bf16_t* kr = KN + (row0 + c) * 256 + h * 64; const bf16_t* qr = QN + (row0 + c) * 256 + h * 64;
#define GDMA(piece, gptr) __builtin_amdgcn_global_load_lds((const unsigned*)(gptr), (LAS unsigned*)(buf + (piece) * 1024), 16, 0, 0)
    GDMA(0, kr + 8 * qd); GDMA(1, kr + 32 + 8 * qd); GDMA(2, qr + 8 * qd); GDMA(3, qr + 32 + 8 * qd);
    GDMA(4, qr + 4 * qd); GDMA(5, qr + 16 + 4 * qd); GDMA(6, qr + 32 + 4 * qd); GDMA(7, qr + 48 + 4 * qd);
#pragma unroll
    for (int rt = 0; rt < 4; ++rt) GDMA(8 + rt, KT + ((size_t)bh * 64 + 16 * rt + c) * SEQ + blk * 16 + 4 * qd);
    GDMA(12, XVT + ((size_t)bh * 64 + lane) * SEQ + blk * 16); GDMA(13, XVT + ((size_t)bh * 64 + lane) * SEQ + blk * 16 + 8);
    GDMA(14, Z + (row0 + (lane >> 3)) * NZ + ZC_DG + h * 64 + 8 * (lane & 7)); GDMA(15, Z + (row0 + 8 + (lane >> 3)) * NZ + ZC_DG + h * 64 + 8 * (lane & 7));
#undef GDMA
}

#ifndef GDN_HILO
#define GDN_HILO 0
#endif
__device__ __forceinline__ float bf_res(float x) { return x - __uint_as_float(__float_as_uint(x) & 0xffff0000u) ; }
__device__ __forceinline__ unsigned pk_trunc(float lo, float hi) { return (__float_as_uint(lo) >> 16) | (__float_as_uint(hi) & 0xffff0000u); }
__device__ __forceinline__ void gdn_seq(const bf16_t* Z, const bf16_t* KT, const bf16_t* QN, const bf16_t* KN, const bf16_t* XVT, const float* AB, const float* gnorm, bf16_t* O,
                                        LAS unsigned char* bufA, LAS unsigned char* bufB, LAS unsigned char* wk, int b, int h, int lane) {
    const int c = lane & 15, qd = lane >> 4;
    LAS float* Lm = (LAS float*)wk; LAS bf16_t* Wl = (LAS bf16_t*)(wk + 1024); LAS float* Ul = (LAS float*)(wk + 3072);
    LAS float* Ee = (LAS float*)(wk + 7168); LAS float* Eb = (LAS float*)(wk + 7232); LAS float* Eg = (LAS float*)(wk + 7296); LAS bf16_t* Wl2 = (LAS bf16_t*)(wk + 7424);
    f32x4 Sacc[4][4];
#pragma unroll
    for (int rt = 0; rt < 4; ++rt)
#pragma unroll
        for (int ct = 0; ct < 4; ++ct) Sacc[rt][ct] = (f32x4){0.f, 0.f, 0.f, 0.f};
    float gn[4];
#pragma unroll
    for (int ct = 0; ct < 4; ++ct) gn[ct] = gnorm[16 * ct + c];
    gdn_dma(bufA, Z, KT, QN, KN, XVT, b, h, 0, lane);
    float g_n = AB[(((size_t)b * SEQ + c) * 4 + h) * 2], beta_n = AB[(((size_t)b * SEQ + c) * 4 + h) * 2 + 1];
    unsigned outp[8];
#pragma unroll
    for (int i = 0; i < 8; ++i) outp[i] = 0u;
    for (int blk = 0; blk < SEQ / 16; ++blk) {
        LAS unsigned char* buf = (blk & 1) ? bufB : bufA;
        const size_t row0 = (size_t)b * SEQ + blk * 16;
        asm volatile("s_waitcnt vmcnt(0)" ::: "memory");
        const float g_t = g_n, beta_t = beta_n;
        if (blk > 0) {
#pragma unroll
            for (int jj = 0; jj < 4; ++jj)
#pragma unroll
                for (int ct = 0; ct < 4; ++ct) { const unsigned w = outp[jj * 2 + (ct >> 1)]; O[(row0 - 16 + 4 * qd + jj) * DM + 512 + h * 64 + 16 * ct + c] = (bf16_t)((ct & 1) ? (w >> 16) : (w & 0xffff)); } }
        if (blk + 1 < SEQ / 16) { gdn_dma((blk & 1) ? bufA : bufB, Z, KT, QN, KN, XVT, b, h, blk + 1, lane);
            g_n = AB[((row0 + 16 + c) * 4 + h) * 2]; beta_n = AB[((row0 + 16 + c) * 4 + h) * 2 + 1]; }
        const float gc = row16_scan(g_t), e_t = __expf(gc);
        const float glast = rdlane(gc, 15), elast = __expf(glast);
        if (lane < 16) { Ee[lane] = e_t; Eb[lane] = beta_t; Eg[lane] = gc; }
        const bf16x8 kf0 = *(const LAS bf16x8*)(buf + 0 * 1024 + lane * 16), kf1 = *(const LAS bf16x8*)(buf + 1 * 1024 + lane * 16);
        const bf16x8 qf0 = *(const LAS bf16x8*)(buf + 2 * 1024 + lane * 16), qf1 = *(const LAS bf16x8*)(buf + 3 * 1024 + lane * 16);
        f32x4 G = (f32x4){0.f, 0.f, 0.f, 0.f}, KQ = (f32x4){0.f, 0.f, 0.f, 0.f};
        G = mfma16x32(kf0, kf0, G); G = mfma16x32(kf1, kf1, G);
        KQ = mfma16x32(kf0, qf0, KQ); KQ = mfma16x32(kf1, qf1, KQ);
        LDS_FENCE();
        float aqv[4], gr4[4], Lv[4];
#pragma unroll
        for (int jj = 0; jj < 4; ++jj) gr4[jj] = Eg[4 * qd + jj];
#pragma unroll
        for (int jj = 0; jj < 4; ++jj) { const int i = 4 * qd + jj;
            Lv[jj] = (c < i) ? Eb[i] * G[jj] * __expf(gr4[jj] - gc) : 0.f;
            aqv[jj] = (i <= c) ? KQ[jj] * __expf(gc - gr4[jj]) : 0.f; }
        const s16x4 aqf = cvt4(aqv[0], aqv[1], aqv[2], aqv[3]);
        LDS_FENCE();
        {
            float xv[16], xu[16], kn[16], xw[16];
            { const u32x4 a = *(const LAS u32x4*)(buf + 12 * 1024 + lane * 16), bq = *(const LAS u32x4*)(buf + 13 * 1024 + lane * 16);
              float t8[8]; unpack8(a, t8);
#pragma unroll
              for (int i = 0; i < 8; ++i) xv[i] = t8[i];
              unpack8(bq, t8);
#pragma unroll
              for (int i = 0; i < 8; ++i) xv[8 + i] = t8[i]; }
            { const int rt = lane >> 4;
#pragma unroll
              for (int q4 = 0; q4 < 4; ++q4) { const u32x2 t2 = *(const LAS u32x2*)(buf + (8 + rt) * 1024 + (q4 * 16 + c) * 16);
                  kn[4 * q4] = bf2f(t2.x & 0xffff); kn[4 * q4 + 1] = bf2f(t2.x >> 16); kn[4 * q4 + 2] = bf2f(t2.y & 0xffff); kn[4 * q4 + 3] = bf2f(t2.y >> 16); } }
            const float be_t = beta_t * e_t;
#pragma unroll
            for (int i = 0; i < 16; ++i) { xu[i] = rdlane(beta_t, i) * xv[i]; xw[i] = rdlane(be_t, i) * kn[i]; }
#pragma unroll
            for (int j = 0; j < 16; ++j) {
#pragma unroll
                for (int i = j + 1; i < 16; ++i) { const float lij = rdlane(Lv[i & 3], (i >> 2) * 16 + j); xu[i] -= lij * xu[j]; xw[i] -= lij * xw[j]; }
                Ul[j * 64 + lane] = xu[j];
                const float nw = -xw[j];
                if (GDN_HILO) { Wl[j * 64 + lane] = (bf16_t)(__float_as_uint(nw) >> 16); Wl2[j * 64 + lane] = (bf16_t)f2bf(bf_res(nw)); } else Wl[j * 64 + lane] = (bf16_t)f2bf(nw);
            }
        }
        LDS_FENCE();
        bf16x8 wfa[2], wfb[2], qfa[2];
#pragma unroll
        for (int ks = 0; ks < 2; ++ks) {
            const u32x2 w0 = *(const LAS u32x2*)(Wl + c * 64 + 32 * ks + 4 * qd), w1 = *(const LAS u32x2*)(Wl + c * 64 + 32 * ks + 16 + 4 * qd);
            wfa[ks] = __builtin_bit_cast(bf16x8, (u32x4){w0.x, w0.y, w1.x, w1.y});
            const u32x2 w2 = *(const LAS u32x2*)(Wl2 + c * 64 + 32 * ks + 4 * qd), w3 = *(const LAS u32x2*)(Wl2 + c * 64 + 32 * ks + 16 + 4 * qd);
            wfb[ks] = __builtin_bit_cast(bf16x8, (u32x4){w2.x, w2.y, w3.x, w3.y});
            const u32x2 q0 = *(const LAS u32x2*)(buf + (4 + 2 * ks) * 1024 + lane * 16), q1_ = *(const LAS u32x2*)(buf + (5 + 2 * ks) * 1024 + lane * 16);
            qfa[ks] = __builtin_bit_cast(bf16x8, (u32x4){q0.x, q0.y, q1_.x, q1_.y});
        }
        float e4[4], sc4[4];
#pragma unroll
        for (int jj = 0; jj < 4; ++jj) { e4[jj] = Ee[4 * qd + jj]; sc4[jj] = __expf(glast - gr4[jj]); }
        f32x4 oacc[4]; s16x4 vsb[4], vsb2[4];
#pragma unroll
        for (int ct = 0; ct < 4; ++ct) {
            f32x4 vn;
#pragma unroll
            for (int jj = 0; jj < 4; ++jj) vn[jj] = Ul[(4 * qd + jj) * 64 + 16 * ct + c];
            f32x4 qs = (f32x4){0.f, 0.f, 0.f, 0.f};
#pragma unroll
            for (int ks = 0; ks < 2; ++ks) {
                const f32x4 lo = Sacc[2 * ks][ct], hi = Sacc[2 * ks + 1][ct];
                const bf16x8 sb = GDN_HILO ? __builtin_bit_cast(bf16x8, (u32x4){pk_trunc(lo[0], lo[1]), pk_trunc(lo[2], lo[3]), pk_trunc(hi[0], hi[1]), pk_trunc(hi[2], hi[3])})
                                           : __builtin_bit_cast(bf16x8, cvt8(lo[0], lo[1], lo[2], lo[3], hi[0], hi[1], hi[2], hi[3]));
                const bf16x8 sb2 = __builtin_bit_cast(bf16x8, cvt8(bf_res(lo[0]), bf_res(lo[1]), bf_res(lo[2]), bf_res(lo[3]), bf_res(hi[0]), bf_res(hi[1]), bf_res(hi[2]), bf_res(hi[3])));
                if (GDN_HILO) { vn = mfma16x32(wfa[ks], sb, vn); vn = mfma16x32(wfa[ks], sb2, vn); vn = mfma16x32(wfb[ks], sb, vn);
                                qs = mfma16x32(qfa[ks], sb, qs); qs = mfma16x32(qfa[ks], sb2, qs); }
                else { vn = mfma16x32(wfa[ks], sb, vn); qs = mfma16x32(qfa[ks], sb, qs); } }
#pragma unroll
            for (int jj = 0; jj < 4; ++jj) qs[jj] *= e4[jj];
            oacc[ct] = mfma16x16(aqf, cvt4(vn[0], vn[1], vn[2], vn[3]), qs);
            const float s0 = vn[0] * sc4[0], s1 = vn[1] * sc4[1], s2 = vn[2] * sc4[2], s3 = vn[3] * sc4[3];
            vsb[ct] = GDN_HILO ? __builtin_bit_cast(s16x4, (u32x2){pk_trunc(s0, s1), pk_trunc(s2, s3)}) : __builtin_bit_cast(s16x4, (u32x2){pk2(s0, s1), pk2(s2, s3)});
            vsb2[ct] = cvt4(bf_res(s0), bf_res(s1), bf_res(s2), bf_res(s3));
            asm volatile("" ::: "memory");
        }
#pragma unroll
        for (int rt = 0; rt < 4; ++rt) {
            const u32x2 k2 = *(const LAS u32x2*)(buf + (8 + rt) * 1024 + lane * 16);
            const s16x4 ktf = __builtin_bit_cast(s16x4, k2);
#pragma unroll
            for (int ct = 0; ct < 4; ++ct) { f32x4 t = mfma16x16(ktf, vsb[ct], Sacc[rt][ct] * elast); Sacc[rt][ct] = GDN_HILO ? mfma16x16(ktf, vsb2[ct], t) : t; }
        }
#pragma unroll
        for (int jj = 0; jj < 4; ++jj) {
            float ss = 0.f;
#pragma unroll
            for (int ct = 0; ct < 4; ++ct) ss += oacc[ct][jj] * oacc[ct][jj];
            const float rn = rsqrtf(row16_sum(ss) * (1.f / 64.f) + EPS);
            const int tok = 4 * qd + jj;
            float ov[4];
#pragma unroll
            for (int ct = 0; ct < 4; ++ct) { const float gt = bf2f(*(const LAS bf16_t*)(buf + 14 * 1024 + tok * 128 + (16 * ct + c) * 2)); ov[ct] = oacc[ct][jj] * rn * gn[ct] * gt * __builtin_amdgcn_rcpf(1.0f + __expf(-gt)); }
            outp[jj * 2] = pk2(ov[0], ov[1]); outp[jj * 2 + 1] = pk2(ov[2], ov[3]);
        }
        LDS_FENCE();
    }
    { const size_t row0 = (size_t)b * SEQ + SEQ;
#pragma unroll
      for (int jj = 0; jj < 4; ++jj)
#pragma unroll
          for (int ct = 0; ct < 4; ++ct) { const unsigned w = outp[jj * 2 + (ct >> 1)]; O[(row0 - 16 + 4 * qd + jj) * DM + 512 + h * 64 + 16 * ct + c] = (bf16_t)((ct & 1) ? (w >> 16) : (w & 0xffff)); } }
}

__device__ __forceinline__ void gla_prep(const bf16_t* Z, const float* Zs, const float* w_lr, const float* b_lr, bf16_t* KUT, bf16_t* QE, bf16_t* KE, float* DEC,
                                         int b, int h, int n, int lane) {
    asm volatile("" : "+v"(lane));
    const int d = lane & 31, half = lane >> 5;
    float wlr[16];
#pragma unroll
    for (int j = 0; j < 16; ++j) wlr[j] = w_lr[j * 128 + h * 32 + d];
    const float bl = b_lr[h * 32 + d];
    for (int bi = 0; bi < 2; ++bi) {
        int blk = n * 4 + half + 2 * bi;
        const size_t row0 = (size_t)b * SEQ + blk * 16;
        float kk[16], bcv[16];
        float bc = 0.f;
#pragma unroll
        for (int i = 0; i < 16; ++i) {
            const float* lr = Zs + (row0 + i) * NZS + ZS_LR;
            const f32x4 l0 = *(const f32x4*)lr, l1 = *(const f32x4*)(lr + 4), l2 = *(const f32x4*)(lr + 8), l3 = *(const f32x4*)(lr + 12);
            float x = bl;
#pragma unroll
            for (int e = 0; e < 4; ++e) x += l0[e] * wlr[e] + l1[e] * wlr[4 + e] + l2[e] * wlr[8 + e] + l3[e] * wlr[12 + e];
            const float ls = fminf(x, 0.f) - log1pf(__expf(-fabsf(x)));
            bc += ls * (1.0f / 16.0f);
            const bf16_t* zr = Z + (row0 + i) * NZ;
            const float q = bf2f(zr[ZC_AQ + h * 32 + d]) * 0.17677669529663687f, k = bf2f(zr[ZC_AK + h * 32 + d]);
            kk[i] = k; bcv[i] = bc;
            QE[(row0 + i) * 128 + h * 32 + d] = (bf16_t)f2bf(q * __expf(bc)); KE[(row0 + i) * 128 + h * 32 + d] = (bf16_t)f2bf(k * __expf(-bc));
        }
        float ku[16];
#pragma unroll
        for (int i = 0; i < 16; ++i) ku[i] = kk[i] * __expf(bc - bcv[i]);
        bf16_t* kr = KUT + (((size_t)b * 4 + h) * 32 + d) * SEQ + blk * 16;
        *(u32x4*)kr = cvt8(ku[0], ku[1], ku[2], ku[3], ku[4], ku[5], ku[6], ku[7]); *(u32x4*)(kr + 8) = cvt8(ku[8], ku[9], ku[10], ku[11], ku[12], ku[13], ku[14], ku[15]);
        DEC[(((size_t)b * (SEQ / 16) + blk) * 4 + h) * 32 + d] = __expf(bc);
    }
}
struct GlaOps { u32x4 qe, ke, v0, v1, r0, r1; u32x2 qa0, qa1, ku0, ku1; };
__device__ __forceinline__ void gla_fetch(GlaOps& t, const bf16_t* Z, const bf16_t* KUT, const bf16_t* QE, const bf16_t* KE, int b, int h, int blk, int lane) {
    asm volatile("" : "+v"(lane));
    const int c = lane & 15, qd = lane >> 4, bh = b * 4 + h;
    const size_t row0 = (size_t)b * SEQ + blk * 16;
    const bf16_t* qr = QE + (row0 + c) * 128 + h * 32; const bf16_t* kr = KE + (row0 + c) * 128 + h * 32;
    t.qe = *(const u32x4*)(qr + 8 * qd); t.ke = *(const u32x4*)(kr + 8 * qd);
    t.qa0 = *(const u32x2*)(qr + 4 * qd); t.qa1 = *(const u32x2*)(qr + 16 + 4 * qd);
    t.ku0 = *(const u32x2*)(KUT + ((size_t)bh * 32 + c) * SEQ + blk * 16 + 4 * qd); t.ku1 = *(const u32x2*)(KUT + ((size_t)bh * 32 + 16 + c) * SEQ + blk * 16 + 4 * qd);
    const bf16_t* zv = Z + (row0 + (lane >> 3)) * NZ + h * 64 + 8 * (lane & 7);
    t.v0 = *(const u32x4*)(zv + ZC_AV); t.v1 = *(const u32x4*)(zv + 8 * NZ + ZC_AV); t.r0 = *(const u32x4*)(zv + ZC_AR); t.r1 = *(const u32x4*)(zv + 8 * NZ + ZC_AR);
}
__device__ __forceinline__ void gla_seq(const bf16_t* Z, const bf16_t* KUT, const bf16_t* QE, const bf16_t* KE, const float* DEC, const float* gnorm, bf16_t* O,
                                        LAS unsigned char* buf, int b, int h, int lane) {
    const int c = lane & 15, qd = lane >> 4;
    f32x4 Sacc[2][4];
#pragma unroll
    for (int rt = 0; rt < 2; ++rt)
#pragma unroll
        for (int ct = 0; ct < 4; ++ct) Sacc[rt][ct] = (f32x4){0.f, 0.f, 0.f, 0.f};
    float gn[4];
#pragma unroll
    for (int ct = 0; ct < 4; ++ct) gn[ct] = gnorm[16 * ct + c];
    GlaOps t;
    gla_fetch(t, Z, KUT, QE, KE, b, h, 0, lane);
    const float* dp = DEC + (((size_t)b * (SEQ / 16)) * 4 + h) * 32 + 4 * qd;
    f32x4 dn0 = *(const f32x4*)dp, dn1 = *(const f32x4*)(dp + 16);
    for (int blk = 0; blk < SEQ / 16; ++blk) {
        const size_t row0 = (size_t)b * SEQ + blk * 16;
        *(LAS u32x4*)(buf + lane * 16) = t.v0; *(LAS u32x4*)(buf + 1024 + lane * 16) = t.v1; *(LAS u32x4*)(buf + 2048 + lane * 16) = t.r0; *(LAS u32x4*)(buf + 3072 + lane * 16) = t.r1;
        const bf16x8 qef = __builtin_bit_cast(bf16x8, t.qe), kef = __builtin_bit_cast(bf16x8, t.ke);
        const bf16x8 qea = __builtin_bit_cast(bf16x8, (u32x4){t.qa0.x, t.qa0.y, t.qa1.x, t.qa1.y});
        const s16x4 kuf0 = __builtin_bit_cast(s16x4, t.ku0), kuf1 = __builtin_bit_cast(s16x4, t.ku1);
        const f32x4 d0 = dn0, d1 = dn1;
        if (blk + 1 < SEQ / 16) { gla_fetch(t, Z, KUT, QE, KE, b, h, blk + 1, lane);
            dn0 = *(const f32x4*)(dp + (size_t)(blk + 1) * 128); dn1 = *(const f32x4*)(dp + (size_t)(blk + 1) * 128 + 16); }
        LDS_FENCE();
        f32x4 att = mfma16x32(kef, qef, (f32x4){0.f, 0.f, 0.f, 0.f});
        const s16x4 attf = cvt4((4 * qd + 0 <= c) ? att[0] : 0.f, (4 * qd + 1 <= c) ? att[1] : 0.f, (4 * qd + 2 <= c) ? att[2] : 0.f, (4 * qd + 3 <= c) ? att[3] : 0.f);
        f32x4 oacc[4]; s16x4 vb[4];
#pragma unroll
        for (int ct = 0; ct < 4; ++ct) {
            const f32x4 lo = Sacc[0][ct], hi = Sacc[1][ct];
            const bf16x8 sb = __builtin_bit_cast(bf16x8, cvt8(lo[0], lo[1], lo[2], lo[3], hi[0], hi[1], hi[2], hi[3]));
            f32x4 qs = mfma16x32(qea, sb, (f32x4){0.f, 0.f, 0.f, 0.f});
            asm volatile("s_nop 15\n\ts_nop 7" : "+v"(qs));
            unsigned short v4[4];
#pragma unroll
            for (int jj = 0; jj < 4; ++jj) v4[jj] = *(const LAS bf16_t*)(buf + (4 * qd + jj) * 128 + (16 * ct + c) * 2);
            vb[ct] = __builtin_bit_cast(s16x4, (u32x2){(unsigned)v4[0] | ((unsigned)v4[1] << 16), (unsigned)v4[2] | ((unsigned)v4[3] << 16)});
            oacc[ct] = mfma16x16(attf, vb[ct], qs);
        }
#pragma unroll
        for (int ct = 0; ct < 4; ++ct) { Sacc[0][ct] = mfma16x16(kuf0, vb[ct], Sacc[0][ct] * d0); Sacc[1][ct] = mfma16x16(kuf1, vb[ct], Sacc[1][ct] * d1); }
#pragma unroll
        for (int jj = 0; jj < 4; ++jj) {
            float ss = 0.f;
#pragma unroll
            for (int ct = 0; ct < 4; ++ct) ss += oacc[ct][jj] * oacc[ct][jj];
            const float rn = rsqrtf(row16_sum(ss) * (1.f / 64.f) + EPS);
            const int tok = 4 * qd + jj;
#pragma unroll
            for (int ct = 0; ct < 4; ++ct) { const float gt = bf2f(*(const LAS bf16_t*)(buf + 2048 + tok * 128 + (16 * ct + c) * 2));
                O[(row0 + tok) * DM + 256 + h * 64 + 16 * ct + c] = (bf16_t)f2bf(oacc[ct][jj] * rn * gn[ct] * gt * __builtin_amdgcn_rcpf(1.0f + __expf(-gt))); }
        }
        LDS_FENCE();
    }
}

__device__ __forceinline__ void cmp1_item(const bf16_t* Z, const bf16_t* Wc1T, float* PH, int kv, int b, int g, int mg, int lane) {
    const int rw = lane & 15, quad = lane >> 4;
    const int m = 16 * mg + rw;
    const bf16_t* zb = Z + (size_t)(b * SEQ + 16 * m) * NZ + (kv ? ZC_NVC : ZC_NKC) + g * 64 + 8 * quad;
    const bf16_t* wb = Wc1T + (size_t)kv * 128 * 1024 + (size_t)rw * 1024 + 8 * quad;
    f32x4 acc[8];
#pragma unroll
    for (int n = 0; n < 8; ++n) acc[n] = (f32x4){0.f, 0.f, 0.f, 0.f};
    for (int ks = 0; ks < 32; ++ks) {
        const bf16x8 a = *(const bf16x8*)(zb + (size_t)(ks >> 1) * NZ + 32 * (ks & 1));
#pragma unroll
        for (int n = 0; n < 8; ++n) { const bf16x8 bb = *(const bf16x8*)(wb + (size_t)(16 * n) * 1024 + 32 * ks); acc[n] = __builtin_amdgcn_mfma_f32_16x16x32_bf16(a, bb, acc[n], 0, 0, 0); }
    }
#pragma unroll
    for (int n = 0; n < 8; ++n)
#pragma unroll
        for (int j = 0; j < 4; ++j) { const int mm = 16 * mg + 4 * quad + j; PH[((((size_t)b * 128 + mm) * 2 + g) * 2 + kv) * 128 + 16 * n + rw] = acc[n][j]; }
}
__device__ __forceinline__ void cmp2_item(const float* PH, const float* C0P, const float* w2, bf16_t* CK, bf16_t* CVT, LAS float* wl, int kv, int b, int g, int n, int lane) {
    if (n == 127) { if (kv == 0) CK[(((size_t)b * 2 + g) * 128 + 127) * 64 + lane] = 0; else CVT[(((size_t)b * 2 + g) * 64 + lane) * 128 + 127] = 0; return; }
    float hid = PH[((((size_t)b * 128 + n) * 2 + g) * 2 + kv) * 128 + lane] + PH[((((size_t)b * 128 + n + 1) * 2 + g) * 2 + kv) * 128 + 64 + lane];
#pragma unroll
    for (int s = 0; s < 8; ++s) hid += C0P[(kv * 8 + s) * 64 + lane];
    wl[lane] = gelu_tanh(hid);
    LDS_FENCE();
    float o = 0.f;
#pragma unroll
    for (int c = 0; c < 16; ++c) { const f32x4 a4 = *(const LAS f32x4*)(wl + 4 * c);
#pragma unroll
        for (int j = 0; j < 4; ++j) o += a4[j] * w2[(kv * 64 + 4 * c + j) * 64 + lane]; }
    LDS_FENCE();
    if (kv == 0) CK[(((size_t)b * 2 + g) * 128 + n) * 64 + lane] = (bf16_t)f2bf(o);
    else CVT[(((size_t)b * 2 + g) * 64 + lane) * 128 + n] = (bf16_t)f2bf(o);
}

__device__ __forceinline__ f32x16 mfma32(bf16x8 a, bf16x8 b, f32x16 c) { return __builtin_amdgcn_mfma_f32_32x32x16_bf16(a, b, c, 0, 0, 0); }
__device__ __forceinline__ bf16x8 pack8f(const float* p) { return __builtin_bit_cast(bf16x8, cvt8(p[0], p[1], p[2], p[3], p[4], p[5], p[6], p[7])); }
template <int D>
__device__ __forceinline__ f32x16 qk_tile(const bf16_t* Kp, int ldk, int key0, const bf16x8 (&qf)[D / 16], int r, int h) {
    const int prow = (r & 19) | ((r & 4) << 1) | ((r & 8) >> 1);
    const bf16_t* kp = Kp + (size_t)(key0 + prow) * ldk + 8 * h;
    f32x16 s;
#pragma unroll
    for (int i = 0; i < 16; ++i) s[i] = 0.f;
#pragma unroll
    for (int k = 0; k < D / 16; ++k) s = mfma32(*(const bf16x8*)(kp + 16 * k), qf[k], s);
    return s;
}
template <int D>
__device__ __forceinline__ void pv_tile(const float* p, f32x16 (&o)[D / 32], const bf16_t* VTp, int ldv, int key0, int r, int h) {
#pragma unroll
    for (int s = 0; s < 2; ++s) { const bf16x8 pb = pack8f(p + 8 * s);
#pragma unroll
        for (int dt = 0; dt < D / 32; ++dt) o[dt] = mfma32(*(const bf16x8*)(VTp + (size_t)(32 * dt + r) * ldv + key0 + 16 * s + 8 * h), pb, o[dt]); }
}
template <int D>
__device__ __forceinline__ void load_k(const bf16_t* Kp, int ldk, int key0, int r, int h, bf16x8 (&kf)[D / 16]) {
    const int prow = (r & 19) | ((r & 4) << 1) | ((r & 8) >> 1);
    const bf16_t* kp = Kp + (size_t)(key0 + prow) * ldk + 8 * h;
#pragma unroll
    for (int k = 0; k < D / 16; ++k) kf[k] = *(const bf16x8*)(kp + 16 * k);
}
template <int D>
__device__ __forceinline__ void load_v(const bf16_t* VTp, int ldv, int key0, int r, int h, bf16x8 (&vf)[2][D / 32]) {
#pragma unroll
    for (int s = 0; s < 2; ++s)
#pragma unroll
        for (int dt = 0; dt < D / 32; ++dt) vf[s][dt] = *(const bf16x8*)(VTp + (size_t)(32 * dt + r) * ldv + key0 + 16 * s + 8 * h);
}
template <int D>
__device__ __forceinline__ f32x16 qk_frag(const bf16x8 (&kf)[D / 16], const bf16x8 (&qf)[D / 16]) {
    f32x16 s;
#pragma unroll
    for (int i = 0; i < 16; ++i) s[i] = 0.f;
#pragma unroll
    for (int k = 0; k < D / 16; ++k) s = mfma32(kf[k], qf[k], s);
    return s;
}
template <int D>
__device__ __forceinline__ void softmax_pv_frag(const f32x16& s, float& m, float& l, f32x16 (&o)[D / 32], const bf16x8 (&vf)[2][D / 32]) {
    float mt = s[0];
#pragma unroll
    for (int i = 1; i < 16; ++i) mt = fmaxf(mt, s[i]);
    mt = fmaxf(mt, __shfl_xor(mt, 32));
    const float mn = fmaxf(m, mt);
    const float mu = (mn == -INFINITY) ? 0.f : mn;
    const float alpha = __builtin_amdgcn_exp2f(m - mu);
    float p[16]; float ps = 0.f;
#pragma unroll
    for (int i = 0; i < 16; ++i) { p[i] = __builtin_amdgcn_exp2f(s[i] - mu); ps += p[i]; }
    l = l * alpha + ps;
#pragma unroll
    for (int dt = 0; dt < D / 32; ++dt)
#pragma unroll
        for (int i = 0; i < 16; ++i) o[dt][i] *= alpha;
#pragma unroll
    for (int sx = 0; sx < 2; ++sx) { const bf16x8 pb = pack8f(p + 8 * sx);
#pragma unroll
        for (int dt = 0; dt < D / 32; ++dt) o[dt] = mfma32(vf[sx][dt], pb, o[dt]); }
    m = mn;
}
template <int D>
__device__ __forceinline__ void softmax_pv(const f32x16& s, float& m, float& l, f32x16 (&o)[D / 32], const bf16_t* VTp, int ldv, int key0, int r, int h) {
    float mt = s[0];
#pragma unroll
    for (int i = 1; i < 16; ++i) mt = fmaxf(mt, s[i]);
    mt = fmaxf(mt, __shfl_xor(mt, 32));
    const float mn = fmaxf(m, mt);
    const float mu = (mn == -INFINITY) ? 0.f : mn;
    const float alpha = __builtin_amdgcn_exp2f(m - mu);
    float p[16]; float ps = 0.f;
#pragma unroll
    for (int i = 0; i < 16; ++i) { p[i] = __builtin_amdgcn_exp2f(s[i] - mu); ps += p[i]; }
    l = l * alpha + ps;
#pragma unroll
    for (int dt = 0; dt < D / 32; ++dt)
#pragma unroll
        for (int i = 0; i < 16; ++i) o[dt][i] *= alpha;
    pv_tile<D>(p, o, VTp, ldv, key0, r, h);
    m = mn;
}

__device__ __forceinline__ void nsa_item(const bf16_t* Z, const float* Zs, const bf16_t* CK, const bf16_t* CVT, const bf16_t* VTS, const bf16_t* VTW, bf16_t* O,
                                         LAS float* wl, int b, int g, int t0, int lane) {
    asm volatile("" : "+v"(lane));
    const int r = lane & 31, h = lane >> 5, tq = t0 + (r & 15), jh = r >> 4;
    const size_t row = (size_t)b * SEQ + tq;
    const float sc = 0.125f * 1.4426950408889634f;
    bf16x8 qf[4];
    { const bf16_t* qp = Z + row * NZ + ZC_NQ + (g * 2 + jh) * 64 + 8 * h;
#pragma unroll
      for (int k = 0; k < 4; ++k) qf[k] = *(const bf16x8*)(qp + 16 * k); }
    const float* gp = Zs + row * NZS + ZS_NG + (g * 2 + jh) * 3;
    const float g0 = sigmoidf_(gp[0]), g1 = sigmoidf_(gp[1]), g2 = sigmoidf_(gp[2]);
    f32x16 oc[2];
    unsigned selmask;
    {
        const bf16_t* Kp = CK + ((size_t)b * 2 + g) * 128 * 64; const bf16_t* VTp = CVT + ((size_t)b * 2 + g) * 64 * 128;
        const int nmax = tq >= 31 ? ((tq - 31) >> 4) : -1;
        f32x16 s[4]; float mx = -INFINITY;
#pragma unroll
        for (int kt = 0; kt < 4; ++kt) { s[kt] = qk_tile<64>(Kp, 64, 32 * kt, qf, r, h);
#pragma unroll
            for (int i = 0; i < 16; ++i) { const int key = 32 * kt + 16 * (i >> 3) + 8 * h + (i & 7); s[kt][i] = key <= nmax ? s[kt][i] * sc : -INFINITY; mx = fmaxf(mx, s[kt][i]); } }
        mx = fmaxf(mx, __shfl_xor(mx, 32));
        const float mu = (mx == -INFINITY) ? 0.f : mx;
        float ps = 0.f;
#pragma unroll
        for (int kt = 0; kt < 4; ++kt)
#pragma unroll
            for (int i = 0; i < 16; ++i) { s[kt][i] = __builtin_amdgcn_exp2f(s[kt][i] - mu); ps += s[kt][i]; }
        ps += __shfl_xor(ps, 32);
        const float inv = ps > 0.f ? 1.0f / ps : 0.f;
        f32x16 o[2];
#pragma unroll
        for (int dt = 0; dt < 2; ++dt)
#pragma unroll
            for (int i = 0; i < 16; ++i) o[dt][i] = 0.f;
#pragma unroll
        for (int kt = 0; kt < 4; ++kt) {
            float p[16];
#pragma unroll
            for (int i = 0; i < 16; ++i) p[i] = s[kt][i] * inv;
            pv_tile<64>(p, o, VTp, 128, 32 * kt, r, h);
#pragma unroll
            for (int q4 = 0; q4 < 4; ++q4) {
                float F = (p[4 * q4] + p[4 * q4 + 1]) + (p[4 * q4 + 2] + p[4 * q4 + 3]), L = p[4 * q4 + 3];
                F += __shfl_xor(F, 16); L += __shfl_xor(L, 16);
                const int mp = 8 * kt + 4 * (q4 >> 1) + 2 * h + (q4 & 1);
                if (r < 16) { wl[r * 32 + mp] = F; wl[512 + r * 32 + mp] = L; }
            }
        }
#pragma unroll
        for (int dt = 0; dt < 2; ++dt)
#pragma unroll
            for (int i = 0; i < 16; ++i) oc[dt][i] = g0 * o[dt][i];
        LDS_FENCE();
        const int tau = lane & 15, q = lane >> 4, tt = t0 + tau, cur = tt >> 6;
        float mine[8];
#pragma unroll
        for (int mm = 0; mm < 8; ++mm) { const int m = 8 * q + mm;
            const float imp = wl[tau * 32 + m] + (m > 0 ? wl[512 + tau * 32 + m - 1] : 0.f);
            const float val = (m == 0 || m == cur || m == cur - 1) ? INFINITY : (m > cur ? -INFINITY : imp);
            mine[mm] = val; wl[1024 + tau * 32 + m] = val; }
        LDS_FENCE();
        float v[32];
#pragma unroll
        for (int c4 = 0; c4 < 8; ++c4) { const f32x4 x = *(const LAS f32x4*)(wl + 1024 + tau * 32 + 4 * c4); v[4 * c4] = x.x; v[4 * c4 + 1] = x.y; v[4 * c4 + 2] = x.z; v[4 * c4 + 3] = x.w; }
        unsigned bits = 0u;
#pragma unroll
        for (int mm = 0; mm < 8; ++mm) { const int m = 8 * q + mm; int cnt = 0;
#pragma unroll
            for (int mp = 0; mp < 32; ++mp) cnt += (v[mp] > mine[mm] || (v[mp] == mine[mm] && mp < m)) ? 1 : 0;
            if (cnt < 16) bits |= 1u << m; }
        bits |= __shfl_xor(bits, 16); bits |= __shfl_xor(bits, 32);
        selmask = bits & ((2u << cur) - 1u);
        LDS_FENCE();
    }
    const int ktmax = (t0 + 15) >> 5;
    {
        const bf16_t* Kp = Z + (size_t)b * SEQ * NZ + ZC_NKS + g * 64; const bf16_t* VTp = VTS + ((size_t)b * 2 + g) * 64 * SEQ;
        float m = -INFINITY, l = 0.f; f32x16 o[2];
#pragma unroll
        for (int dt = 0; dt < 2; ++dt)
#pragma unroll
            for (int i = 0; i < 16; ++i) o[dt][i] = 0.f;
        unsigned um = selmask;
        um |= __shfl_xor(um, 1); um |= __shfl_xor(um, 2); um |= __shfl_xor(um, 4); um |= __shfl_xor(um, 8);
        um = (unsigned)__builtin_amdgcn_readfirstlane((int)um);
        bf16x8 kf[4], kfn[4], vf[2][2];
        int kt = 0;
        load_k<64>(Kp, NZ, 0, r, h, kf);
        while (kt >= 0) {
            int ktn = kt + 1;
            while (ktn <= ktmax && !((um >> (ktn >> 1)) & 1u)) ktn = (ktn | 1) + 1;
            if (ktn > ktmax) ktn = -1;
            load_v<64>(VTp, SEQ, 32 * kt, r, h, vf);
            if (ktn >= 0) load_k<64>(Kp, NZ, 32 * ktn, r, h, kfn);
            const bool sel = (selmask >> (kt >> 1)) & 1u;
            f32x16 s = qk_frag<64>(kf, qf);
            if (32 * kt + 31 <= t0) {
                const float scl = sel ? sc : 0.f, bia = sel ? 0.f : -INFINITY;
#pragma unroll
                for (int i = 0; i < 16; ++i) s[i] = s[i] * scl + bia;
            } else {
#pragma unroll
                for (int i = 0; i < 16; ++i) { const int key = 32 * kt + 16 * (i >> 3) + 8 * h + (i & 7); s[i] = (sel && key <= tq) ? s[i] * sc : -INFINITY; } }
            softmax_pv_frag<64>(s, m, l, o, vf);
            if (ktn >= 0) {
#pragma unroll
                for (int k = 0; k < 4; ++k) kf[k] = kfn[k]; }
            kt = ktn;
        }
        l += __shfl_xor(l, 32);
        const float f = l > 0.f ? g1 / l : 0.f;
#pragma unroll
        for (int dt = 0; dt < 2; ++dt)
#pragma unroll
            for (int i = 0; i < 16; ++i) oc[dt][i] += f * o[dt][i];
    }
    {
        const bf16_t* Kp = Z + (size_t)b * SEQ * NZ + ZC_NKW + g * 64; const bf16_t* VTp = VTW + ((size_t)b * 2 + g) * 64 * SEQ;
        float m = -INFINITY, l = 0.f; f32x16 o[2];
#pragma unroll
        for (int dt = 0; dt < 2; ++dt)
#pragma unroll
            for (int i = 0; i < 16; ++i) o[dt][i] = 0.f;
        const int ktlo = (t0 - 511) > 0 ? ((t0 - 511) >> 5) : 0;
        bf16x8 kf[4], kfn[4], vf[2][2];
        load_k<64>(Kp, NZ, 32 * ktlo, r, h, kf);
        for (int kt = ktlo; kt <= ktmax; ++kt) {
            load_v<64>(VTp, SEQ, 32 * kt, r, h, vf);
            if (kt < ktmax) load_k<64>(Kp, NZ, 32 * (kt + 1), r, h, kfn);
            f32x16 s = qk_frag<64>(kf, qf);
            if (32 * kt + 31 <= t0 && 32 * kt > t0 + 15 - 512) {
#pragma unroll
                for (int i = 0; i < 16; ++i) s[i] *= sc;
            } else {
#pragma unroll
                for (int i = 0; i < 16; ++i) { const int key = 32 * kt + 16 * (i >> 3) + 8 * h + (i & 7); s[i] = (key <= tq && key > tq - 512) ? s[i] * sc : -INFINITY; } }
            softmax_pv_frag<64>(s, m, l, o, vf);
            if (kt < ktmax) {
#pragma unroll
                for (int k = 0; k < 4; ++k) kf[k] = kfn[k]; }
        }
        l += __shfl_xor(l, 32);
        const float f = l > 0.f ? g2 / l : 0.f;
#pragma unroll
        for (int dt = 0; dt < 2; ++dt)
#pragma unroll
            for (int i = 0; i < 16; ++i) oc[dt][i] += f * o[dt][i];
    }
    bf16_t* op = O + row * DM + 768 + (g * 2 + jh) * 64 + 4 * h;
#pragma unroll
    for (int dt = 0; dt < 2; ++dt)
#pragma unroll
        for (int q4 = 0; q4 < 4; ++q4) { u32x2 w; w.x = pk2(oc[dt][4 * q4], oc[dt][4 * q4 + 1]); w.y = pk2(oc[dt][4 * q4 + 2], oc[dt][4 * q4 + 3]); *(u32x2*)(op + 32 * dt + 8 * q4) = w; }
}

__device__ __forceinline__ void xattn_item(bf16_t* XQ, const bf16_t* KV, const bf16_t* VTm, int rt, int hh, int lane) {
    asm volatile("" : "+v"(lane));
    const int r = lane & 31, h = lane >> 5;
    const size_t row = (size_t)rt * 32 + r; const int b = (int)(row >> 11);
    bf16x8 qf[8];
    { const bf16_t* qp = XQ + row * 512 + hh * 128 + 8 * h;
#pragma unroll
      for (int k = 0; k < 8; ++k) qf[k] = *(const bf16x8*)(qp + 16 * k); }
    const bf16_t* Kp = KV + (size_t)b * MEML * DM + hh * 128; const bf16_t* VTp = VTm + ((size_t)b * 4 + hh) * 128 * MEML;
    const float sc = 0.08838834764831845f * 1.4426950408889634f;
    float m = -INFINITY, l = 0.f; f32x16 o[4];
#pragma unroll
    for (int dt = 0; dt < 4; ++dt)
#pragma unroll
        for (int i = 0; i < 16; ++i) o[dt][i] = 0.f;
    bf16x8 kf[8], kfn[8], vf[2][4];
    load_k<128>(Kp, DM, 0, r, h, kf);
    for (int kt = 0; kt < 8; ++kt) {
        load_v<128>(VTp, MEML, 32 * kt, r, h, vf);
        if (kt < 7) load_k<128>(Kp, DM, 32 * (kt + 1), r, h, kfn);
        f32x16 s = qk_frag<128>(kf, qf);
#pragma unroll
        for (int i = 0; i < 16; ++i) s[i] *= sc;
        softmax_pv_frag<128>(s, m, l, o, vf);
        if (kt < 7) {
#pragma unroll
            for (int k = 0; k < 8; ++k) kf[k] = kfn[k]; }
    }
    l += __shfl_xor(l, 32);
    const float f = 1.0f / l;
    bf16_t* op = XQ + row * 512 + hh * 128 + 4 * h;
#pragma unroll
    for (int dt = 0; dt < 4; ++dt)
#pragma unroll
        for (int q4 = 0; q4 < 4; ++q4) { u32x2 w; w.x = pk2(o[dt][4 * q4] * f, o[dt][4 * q4 + 1] * f); w.y = pk2(o[dt][4 * q4 + 2] * f, o[dt][4 * q4 + 3] * f); *(u32x2*)(op + 32 * dt + 8 * q4) = w; }
}

__device__ __forceinline__ void act_item(const bf16_t* UV, bf16_t* ACT, const float* cw, const float* cb, int rb, int cg) {
    const int c0 = cg * 8, ucol = (c0 >> 7) * 256 + (c0 & 127);
    float w0[8], w1[8], w2[8], bb[8];
#pragma unroll
    for (int j = 0; j < 8; ++j) { w0[j] = cw[c0 + j]; w1[j] = cw[DFF + c0 + j]; w2[j] = cw[2 * DFF + c0 + j]; bb[j] = cb[c0 + j]; }
    float u1[8], u2[8];
    const int r0 = rb * 32;
    const bool seq_start = (r0 & (SEQ - 1)) == 0;
    {
        u32x4 a = (u32x4){0u, 0u, 0u, 0u}, c = (u32x4){0u, 0u, 0u, 0u};
        if (!seq_start) { a = *(const u32x4*)(UV + (size_t)(r0 - 1) * NUP + ucol); c = *(const u32x4*)(UV + (size_t)(r0 - 2) * NUP + ucol); }
        unpack8(a, u1); unpack8(c, u2);
    }
    for (int rq = 0; rq < 8; ++rq) {
        u32x4 ua[4], va[4];
#pragma unroll
        for (int i = 0; i < 4; ++i) { const size_t row = (size_t)r0 + rq * 4 + i; ua[i] = *(const u32x4*)(UV + row * NUP + ucol); va[i] = *(const u32x4*)(UV + row * NUP + ucol + 128); }
#pragma unroll
        for (int i = 0; i < 4; ++i) {
            const size_t row = (size_t)r0 + rq * 4 + i;
            float u0[8], vv[8], o[8];
            unpack8(ua[i], u0); unpack8(va[i], vv);
#pragma unroll
            for (int j = 0; j < 8; ++j) { const float x = w0[j] * u2[j] + w1[j] * u1[j] + w2[j] * u0[j] + bb[j]; o[j] = gelu_tanh(x) * vv[j]; u2[j] = u1[j]; u1[j] = u0[j]; }
            *(u32x4*)(ACT + row * DFF + c0) = cvt8(o[0], o[1], o[2], o[3], o[4], o[5], o[6], o[7]);
        }
    }
}

__device__ __forceinline__ void ffn_fix_item(const float* stash, bf16_t* ACT, const float* cw, const float* cb, int it) {
    const int cg = it & 15, j = (it >> 4) % 22, pm = it / (16 * 22), c0 = 128 * j + 8 * cg;
    const float* st = stash + ((size_t)(pm * 22 + j) * 6) * 128 + 8 * cg;
    float u0[8], u1[8], v0[8], v1[8], pa[8], pb[8];
#pragma unroll
    for (int e = 0; e < 8; ++e) { u0[e] = st[e]; u1[e] = st[128 + e]; v0[e] = st[4 * 128 + e]; v1[e] = st[5 * 128 + e]; pa[e] = 0.f; pb[e] = 0.f; }
    if (pm & 7) { const float* sp = stash + ((size_t)((pm - 1) * 22 + j) * 6) * 128 + 8 * cg;
#pragma unroll
        for (int e = 0; e < 8; ++e) { pa[e] = sp[2 * 128 + e]; pb[e] = sp[3 * 128 + e]; } }
    float o0[8], o1[8];
#pragma unroll
    for (int e = 0; e < 8; ++e) { const float w0 = cw[c0 + e], w1 = cw[DFF + c0 + e], w2 = cw[2 * DFF + c0 + e], b = cb[c0 + e];
        o0[e] = gelu_tanh(w0 * pa[e] + w1 * pb[e] + w2 * u0[e] + b) * v0[e];
        o1[e] = gelu_tanh(w0 * pb[e] + w1 * u0[e] + w2 * u1[e] + b) * v1[e]; }
    *(u32x4*)(ACT + (size_t)(pm * 256) * DFF + c0) = cvt8(o0[0], o0[1], o0[2], o0[3], o0[4], o0[5], o0[6], o0[7]);
    *(u32x4*)(ACT + (size_t)(pm * 256 + 1) * DFF + c0) = cvt8(o1[0], o1[1], o1[2], o1[3], o1[4], o1[5], o1[6], o1[7]);
}

constexpr int PH_PRO = 0, PH_MEMKV = 1, PH_VTMEM = 2, PH_L0 = 3, NPL = 18, NPH = PH_L0 + NLAYER * NPL;

__global__ void __launch_bounds__(NWAVES * 64, 2) fwd_kernel(Args args) {
    extern __shared__ __attribute__((aligned(16))) unsigned char lds_raw[];
    LAS unsigned char* lds = (LAS unsigned char*)lds_raw;
    const int tid0 = threadIdx.x, wave0 = __builtin_amdgcn_readfirstlane(tid0 >> 6);
    constexpr int G = 256;
    const int vcu0 = (G % 8 == 0) ? ((int)blockIdx.x % 8) * (G / 8) + (int)blockIdx.x / 8 : (int)blockIdx.x;
    constexpr int NGW = G * NWAVES;
#define PH_VARS int wave = wave0, vcu = vcu0; asm volatile("" : "+s"(wave), "+s"(vcu)); \
    int tid = wave * 64 + (int)__builtin_amdgcn_mbcnt_hi(~0u, __builtin_amdgcn_mbcnt_lo(~0u, 0u)); asm volatile("" : "+v"(tid));     \
    unsigned char* ws = ws0; float* X = X0; asm volatile("" : "+s"(ws), "+s"(X)); (void)X; \
    const int lane = tid & 63, gw = vcu * NWAVES + wave; LAS unsigned char* wlds = lds + wave * 16384; (void)lane; (void)gw; (void)wlds;
#define PH_VARS_L PH_VARS int l = l0; asm volatile("" : "+s"(l)); unsigned char* wbase = ws + WS_W + (size_t)l * W_STRIDE; (void)wbase;
    unsigned char* ws0 = args.ws;
    float* X0 = args.out;
    for (int u = tid0; u < (LDS_BYTES - RING_BYTES) / 4; u += NWAVES * 64) ((LAS unsigned*)(lds + RING_BYTES))[u] = 0u;
    __syncthreads();
    XcdBarrier bar; bar.bar = (unsigned*)(ws0 + WS_CTL) + CW_BAR; bar.x = 0; bar.st = nullptr;
    if (args.use_bar) bar = xcd_barrier_post((unsigned*)(ws0 + WS_CTL) + CW_BAR, (volatile LAS unsigned*)(lds + MISC_OFF) + 8);
    const int lo = args.ph_lo, hi = args.ph_hi;
#define IN(k) (lo <= (k) && (k) < hi)
#define REPF(bit) for (int rp_ = 0; rp_ <= ((args.rep_mix >> (bit)) & 1); ++rp_)
#define SEAM(k) do { if (IN(k) && IN((k) + 1)) xcd_barrier(bar); } while (0)

#define Hb ((bf16_t*)(ws + WS_H))
#define Zb ((bf16_t*)(ws + WS_Z))
#define Ob ((bf16_t*)(ws + WS_O))
#define Yb ((bf16_t*)(ws + WS_Y))
#define Zs ((float*)(ws + WS_ZS))
#define XQ ((bf16_t*)(ws + WS_XQ))
#define CK ((bf16_t*)(ws + WS_CK))
#define CVT ((bf16_t*)(ws + WS_CVT))
#define PH ((float*)(ws + WS_PH))
#define VTS ((bf16_t*)(ws + WS_VTS))
#define VTW ((bf16_t*)(ws + WS_VTW))
#define MemKV ((bf16_t*)(ws + WS_MEMKV))
#define VTmem ((bf16_t*)(ws + WS_VTMEM))
#define MemN ((bf16_t*)(ws + WS_MEMN))
#define C0P ((float*)(ws + WS_C0P))
#define UV ((bf16_t*)(ws + WS_UV))
#define ACT ((bf16_t*)(ws + WS_ACT))

    if (IN(PH_PRO)) { PH_VARS
        LAS float* scr = (LAS float*)wlds;
        int base = 0;
        for (int l = 0; l < NLAYER; ++l)
            for (int j = 0; j < 19; ++j) {
                const TrJob q = tr_job(args, ws, l, j);
                int it = (gw - base) % NGW; if (it < 0) it += NGW;
                for (; it < q.nitems; it += NGW) tr_item(q.W, q.ldw, q.WT, q.ldd, q.dk0, q.map, q.r_off, q.nkb, it, q.gk, scr, lane);
                base = (base + q.nitems) % NGW;
            }
        for (int it = gw; it < NLAYER * 2 * 8; it += NGW) {
            const int l = it >> 4, kv = (it >> 3) & 1, s = it & 7;
            const float* pe = args.in[13] + ((size_t)l * 2 + kv) * 32 * 64 + (size_t)s * 4 * 64;
            const float* w1 = args.in[14] + ((size_t)l * 2 + kv) * 2048 * 64 + (size_t)s * 4 * 64 * 64;
            float a = 0.f;
            for (int i = 0; i < 256; ++i) a += pe[i] * w1[(size_t)i * 64 + lane];
            C0P[(size_t)it * 64 + lane] = a;
        }
        for (int m = gw; m < NLAYER * NB * MEML; m += NGW) { const int l = m / (NB * MEML), rr = m % (NB * MEML);
            rms_row_bf16(args.in[1] + (size_t)rr * DM, args.in[21] + (size_t)l * DM, MemN + (size_t)m * DM, lane); }
        for (int m = gw; m < T; m += NGW) xg_row_bf16(args.in[0] + (size_t)m * DM, nullptr, Hb + (size_t)m * DM, (ssq_t*)(ws + WS_SS) + m, lane);
    }
    SEAM(PH_PRO);
    if (IN(PH_MEMKV)) { PH_VARS
        const int l = vcu >> 7, rr = vcu & 127, pm = rr >> 2, pn = rr & 3;
        pg8::SchedOne S{(const char*)(MemN + ((size_t)l * 8192 + pm * 256) * DM), (const char*)(ws + WS_W + (size_t)l * W_STRIDE + WO_KV) + (size_t)pn * 256 * DM * 2, 16, pm * 256, pn * 256};
        pg8::EpiBf16S E{MemKV + (size_t)l * 8192 * DM, DM, nullptr, 0};
        for (int rep = 0; rep <= ((args.rep_gemm >> 4) & 1); ++rep) { int tid_r = tid; asm volatile("" : "+v"(tid_r)); pg8::gemm_phase(lds, tid_r, DM, S, E); }
    }
    SEAM(PH_MEMKV);
    if (IN(PH_VTMEM)) { PH_VARS
        for (int it = gw; it < NLAYER * NB * 4 * 4 * 2; it += NGW) {
            const int db = it & 1, kb = (it >> 1) & 3, hh = (it >> 3) & 3, b = (it >> 5) & 31, l = it >> 10;
            tr64(MemKV + ((size_t)l * 8192 + b * MEML + kb * 64) * DM + 512 + hh * 128 + db * 64, DM,
                 VTmem + ((((size_t)l * NB + b) * 4 + hh) * 128 + db * 64) * MEML + kb * 64, MEML, (LAS bf16_t*)wlds, lane);
        }
    }
    SEAM(PH_VTMEM);

    for (int l0 = 0; l0 < NLAYER; ++l0) {
        const int pb = PH_L0 + l0 * NPL;
        if (IN(pb + 0)) { PH_VARS_L
            pg8::SchedG S{(const char*)Hb, (const char*)(wbase + WO_IN), DM, 16, 13, 32, 8, 0, 0, vcu >> 5, vcu & 31, 1};
            pg8::EpiZ E{Zb, Zs, (const ssq_t*)(ws + WS_SS)};
            for (int rep = 0; rep <= ((args.rep_gemm >> 0) & 1); ++rep) { int tid_r = tid; asm volatile("" : "+v"(tid_r)); S.hot = rep & (args.rep_gemm >> 10); pg8::gemm_phase(lds, tid_r, DM, S, E, (args.rep_gemm >> 8) & 1); }
        }
        SEAM(pb + 0);
        for (int rep = 0; rep <= (args.rep_mix & 1); ++rep) {
        if (IN(pb + 1)) { PH_VARS_L
            for (int i = vcu * 512 + tid; i < 2 * T; i += G * 512) ((ssq_t*)(ws + WS_SS))[T + i] = 0ull;
            REPF(9) for (int it = gw; it < 2 * NB * 2 * 8; it += NGW) { const int mg = it & 7, g = (it >> 3) & 1, b = (it >> 4) & 31, kv = it >> 9;
                cmp1_item(Zb, (const bf16_t*)(wbase + WO_C1), PH, kv, b, g, mg, lane); }
            REPF(9) for (int it = gw; it < 2 * NB * 2 * 32; it += NGW) { const int tb = it & 31, g = (it >> 5) & 1, b = (it >> 6) & 31, sel = it >> 11;
                tr64(Zb + (size_t)(b * SEQ + tb * 64) * NZ + (sel ? ZC_NVW : ZC_NVS) + g * 64, NZ, (sel ? VTW : VTS) + ((size_t)b * 2 + g) * 64 * SEQ + tb * 64, SEQ, (LAS bf16_t*)wlds, lane); }
            REPF(5) for (int it = gw; it < NB * 4 * 32; it += NGW) { const int n = it & 31, h = (it >> 5) & 3, b = it >> 7;
                gdn_prep(Zb, Zs, args.in[9] + (size_t)l * 4 * 768, args.in[10] + (size_t)l * 4, args.in[11] + (size_t)l * 4,
                         (bf16_t*)(ws + WS_GDN_KT), (bf16_t*)(ws + WS_GDN_QN), (bf16_t*)(ws + WS_GDN_KN), (bf16_t*)(ws + WS_GDN_XVT), (float*)(ws + WS_GDN_AB), b, h, n, lane); }
            REPF(6) for (int it = gw; it < NB * 4 * 32; it += NGW) { const int n = it & 31, h = (it >> 5) & 3, b = it >> 7;
                gla_prep(Zb, Zs, args.in[6] + (size_t)l * 16 * 128, args.in[7] + (size_t)l * 128, (bf16_t*)(ws + WS_GLA_KUT), (bf16_t*)(ws + WS_GLA_QE), (bf16_t*)(ws + WS_GLA_KE), (float*)(ws + WS_GLA_DEC), b, h, n, lane); }
        }
        SEAM(pb + 1);
        if (IN(pb + 2)) { PH_VARS_L
            for (int it = gw; it < 2 * NB * 2 * 128; it += NGW) { const int n = it & 127, g = (it >> 7) & 1, b = (it >> 8) & 31, kv = it >> 13;
                cmp2_item(PH, C0P + (size_t)l * 2 * 8 * 64, args.in[15] + (size_t)l * 2 * 64 * 64, CK, CVT, (LAS float*)(lds + RING_BYTES + 1024) + wave * 64, kv, b, g, n, lane); }
        }
        SEAM(pb + 2);
        if (IN(pb + 3)) { PH_VARS_L
            if (wave == 0 && vcu < 128)
              REPF(3)
                gdn_seq(Zb, (const bf16_t*)(ws + WS_GDN_KT), (const bf16_t*)(ws + WS_GDN_QN), (const bf16_t*)(ws + WS_GDN_KN), (const bf16_t*)(ws + WS_GDN_XVT), (const float*)(ws + WS_GDN_AB),
                        args.in[12] + (size_t)l * 64, Ob, lds, lds + RING_BYTES + 4096, lds + RING_BYTES + 4096 + 16384, vcu >> 2, vcu & 3, lane);
            if (wave == 0 && vcu >= 128)
              REPF(4)
                gla_seq(Zb, (const bf16_t*)(ws + WS_GLA_KUT), (const bf16_t*)(ws + WS_GLA_QE), (const bf16_t*)(ws + WS_GLA_KE), (const float*)(ws + WS_GLA_DEC), args.in[8] + (size_t)l * 64, Ob,
                        lds, (vcu - 128) >> 2, (vcu - 128) & 3, lane);
            unsigned* qhead = (unsigned*)(ws + WS_CTL) + CW_QUEUE + 64 * l;
            for (;;) {
                unsigned it = 0u;
                if (lane == 0) it = __hip_atomic_fetch_add(qhead, 1u, __ATOMIC_RELAXED, __HIP_MEMORY_SCOPE_AGENT);
                it = (unsigned)__builtin_amdgcn_readfirstlane((int)it);
                if (it >= (unsigned)(NB * 2 * 128 + NB * 4 * 32)) break;
                if (it < (unsigned)(NB * 2 * 128)) { const int bg = it & 63, tb = 127 - (int)(it >> 6);
                  nsa_item(Zb, Zs, CK, CVT, VTS, VTW, Ob, (LAS float*)wlds, bg >> 1, bg & 1, tb * 16, lane); }
                else { const int i2 = (int)it - NB * 2 * 128, tb = i2 & 31, g = (i2 >> 5) & 3, b = i2 >> 7;
                  pool_item(Zb, Ob, args.in[4] + (size_t)l * 4 * 64 * 64, args.in[5] + (size_t)l * 256, (LAS float*)wlds, b, g, tb * 64, lane); }
            }
        }
        SEAM(pb + 3);
        }
        if (IN(pb + 4)) { PH_VARS_L
            pg8::SchedY2 S{(const char*)Hb, (const char*)Ob, (const char*)(wbase + WO_B), (const char*)(wbase + WO_G), vcu >> 5, vcu & 31};
            unsigned char* scr = ws + WS_SCR + (size_t)vcu * (512 * 1024);
            pg8::EpiY E{Yb, args.in[18] + (size_t)l * 4 * DM, (const ssq_t*)(ws + WS_SS), __builtin_amdgcn_make_buffer_rsrc((void*)scr, 0, 512 * 1024, 0x00020000)};
            for (int rep = 0; rep <= ((args.rep_gemm >> 1) & 1); ++rep) { int tid_r = tid; asm volatile("" : "+v"(tid_r)); pg8::gemm_phase(lds, tid_r, DM, S, E, (args.rep_gemm >> 9) & 1); }
        }
        SEAM(pb + 4);
        if (IN(pb + 5)) { PH_VARS_L
            pg8::SchedG S{(const char*)Yb, (const char*)(wbase + WO_OUT), DM, 16, 4, 32, 8, 0, 0, vcu >> 5, vcu & 31, 0};
            pg8::EpiRes E{(l == 0) ? args.in[0] : nullptr, nullptr, Hb, (ssq_t*)(ws + WS_SS) + T};
            pg8::gemm_phase(lds, tid, DM, S, E);
        }
        SEAM(pb + 5);
        if (IN(pb + 7)) { PH_VARS_L
            pg8::SchedG S{(const char*)Hb, (const char*)(wbase + WO_XQ), DM, 16, 2, 32, 16, 0, 0, vcu >> 5, vcu & 31, 0};
            pg8::EpiBf16S E{XQ, 512, (const ssq_t*)(ws + WS_SS) + T, 0};
            for (int rep = 0; rep <= ((args.rep_gemm >> 2) & 1); ++rep) { int tid_r = tid; asm volatile("" : "+v"(tid_r)); pg8::gemm_phase(lds, tid_r, DM, S, E); }
        }
        SEAM(pb + 7);
        if (IN(pb + 8)) { PH_VARS_L
            for (int i = vcu * 512 + tid; i < T; i += G * 512) ((ssq_t*)(ws + WS_SS))[i] = 0ull;
            for (int it = gw; it < (T / 32) * 4; it += NGW) xattn_item(XQ, MemKV + (size_t)l * 8192 * DM, VTmem + (size_t)l * NB * 4 * 128 * MEML, it >> 2, it & 3, lane);
        }
        SEAM(pb + 8);
        if (IN(pb + 9)) { PH_VARS_L
            pg8::SchedG S{(const char*)XQ, (const char*)(wbase + WO_XO), 512, 8, 4, 32, 8, 0, 0, vcu >> 5, vcu & 31, 0};
            pg8::EpiRes E{nullptr, nullptr, Hb, (ssq_t*)(ws + WS_SS) + 2 * T};
            pg8::gemm_phase(lds, tid, 512, S, E);
        }
        SEAM(pb + 9);
        if (IN(pb + 11)) { PH_VARS_L
            unsigned keep0 = 0u, keep1 = 0u;
            if (tid == 0) { keep0 = ((volatile LAS unsigned*)(lds + MISC_OFF))[8]; keep1 = ((volatile LAS unsigned*)(lds + MISC_OFF))[9]; }
            __syncthreads();
            pg8::SchedG S{(const char*)Hb, (const char*)(wbase + WO_UP), DM, 16, 22, 32, 8, 0, 0, vcu >> 5, vcu & 31, 0};
            pg8::EpiUp E{ACT, (const ssq_t*)(ws + WS_SS) + 2 * T, args.in[27] + (size_t)l * 3 * DFF, args.in[28] + (size_t)l * DFF, (float*)(ws + WS_STASH), lds + RING_BYTES};
            for (int rep = 0; rep <= ((args.rep_gemm >> 3) & 1); ++rep) { int tid_r = tid; asm volatile("" : "+v"(tid_r)); pg8::gemm_phase(lds, tid_r, DM, S, E); }
            __syncthreads();
            if (tid == 0) { ((volatile LAS unsigned*)(lds + MISC_OFF))[8] = keep0; ((volatile LAS unsigned*)(lds + MISC_OFF))[9] = keep1; }
            __syncthreads();
        }
        SEAM(pb + 11);
        if (IN(pb + 12)) { PH_VARS_L
            for (int it = vcu * 512 + tid; it < 256 * 22 * 16; it += G * 512) ffn_fix_item((const float*)(ws + WS_STASH), ACT, args.in[27] + (size_t)l * 3 * DFF, args.in[28] + (size_t)l * DFF, it);
        }
        SEAM(pb + 12);
        if (IN(pb + 13)) { PH_VARS_L
            pg8::SchedG S{(const char*)ACT, (const char*)(wbase + WO_DN), DFF, 44, 4, 32, 8, 0, 0, vcu >> 5, vcu & 31, 0};
            pg8::EpiRes E{nullptr, (l + 1 < NLAYER) ? nullptr : X, Hb, (ssq_t*)(ws + WS_SS)};
            pg8::gemm_phase(lds, tid, DFF, S, E);
        }
        SEAM(pb + 13);
        if (IN(pb + 17)) { PH_VARS_L
            if (l + 1 == NLAYER) { for (int m = gw; m < T; m += NGW) rms_row_f32(X + (size_t)m * DM, args.in[30], lane); }
        }
        SEAM(pb + 17);
    }
#undef IN
#undef SEAM
}
#undef Hb
#undef Zb
#undef Ob
#undef Yb
#undef Zs
#undef XQ
#undef CK
#undef CVT
#undef PH
#undef VTS
#undef VTW
#undef MemKV
#undef VTmem
#undef MemN
#undef C0P
#undef UV
#undef ACT
#undef PH_VARS
#undef PH_VARS_L

extern "C" void kernel_launch(void* const* d_in, const int* in_sizes, int n_in, void* d_out, int out_size, void* d_ws, size_t ws_size, hipStream_t stream) {
    static int grid = 0;
    if (grid == 0) {
        if (n_in != 31 || out_size != T * DM || ws_size < WS_END) { fprintf(stderr, "kernel_launch: unexpected shapes (n_in %d, out %d, ws %zu); nothing launched\n", n_in, out_size, ws_size); grid = -1; return; }
        int dev = 0, cus = 0;
        if (hipGetDevice(&dev) != hipSuccess || hipDeviceGetAttribute(&cus, hipDeviceAttributeMultiprocessorCount, dev) != hipSuccess) { grid = -1; return; }
        if (hipFuncSetAttribute((const void*)fwd_kernel, hipFuncAttributeMaxDynamicSharedMemorySize, LDS_BYTES) != hipSuccess) { grid = -1; return; }
        int per_cu = 0;
        (void)hipOccupancyMaxActiveBlocksPerMultiprocessor(&per_cu, (const void*)fwd_kernel, NWAVES * 64, LDS_BYTES);
        (void)hipGetLastError();
        grid = (cus == 256 && per_cu >= 1) ? 256 : -1;
        if (grid < 0) { fprintf(stderr, "kernel_launch: needs 256 CUs with one resident workgroup each (cus %d, per_cu %d)\n", cus, per_cu); return; }
    }
    if (grid < 0) return;
    (void)hipMemsetAsync((char*)d_ws + WS_CTL, 0, CTL_ZERO_BYTES, stream);
    Args a{};
    for (int i = 0; i < 31; ++i) a.in[i] = (const float*)d_in[i];
    a.out = (float*)d_out; a.ws = (unsigned char*)d_ws; a.rep_gemm = PROBE_REP_GEMM; a.rep_mix = PROBE_REP_MIX; a.rep_mem = PROBE_REP_MEM;
#if MK_N_LAUNCHES == 1
    a.ph_lo = 0; a.ph_hi = NPH; a.use_bar = 1;
    hipLaunchKernelGGL(fwd_kernel, dim3(grid), dim3(NWAVES * 64), LDS_BYTES, stream, a);
#else
    for (int p = 0; p < NPH; ++p) { a.ph_lo = p; a.ph_hi = p + 1; a.use_bar = 0; hipLaunchKernelGGL(fwd_kernel, dim3(grid), dim3(NWAVES * 64), LDS_BYTES, stream, a); }
#endif
}
```
